# Optimizing an MI355X kernel written in HIP

```python
import jax, jax.numpy as jnp
from jax import lax
import numpy as np

D_MODEL = 1024
BATCH = 8
SEQ = 4096
DEPTH = 1

W_A = 1024
W_B = 1024
K_A = 3
K_B = 31
N_GROUPS_A = 16
N_GROUPS_B = 16
EPS = 1e-6
SPLIT_SIZES = (W_A, W_A, W_A, W_A, W_B, W_B, W_B, D_MODEL, D_MODEL)
D_IN = sum(SPLIT_SIZES)

kernel_name = "hybrid_shortconv_conformer_gated_block"


def rms_norm(x, gain):
    xf = x.astype(jnp.float32)
    y = xf * lax.rsqrt(jnp.mean(xf * xf, axis=-1, keepdims=True) + EPS)
    return (y * gain.astype(jnp.float32)).astype(x.dtype)


def layer_norm(x, gain, bias):
    xf = x.astype(jnp.float32)
    mu = jnp.mean(xf, axis=-1, keepdims=True)
    var = jnp.mean(jnp.square(xf - mu), axis=-1, keepdims=True)
    y = (xf - mu) * lax.rsqrt(var + EPS)
    return (y * gain.astype(jnp.float32) + bias.astype(jnp.float32)).astype(x.dtype)


def depthwise_conv_centred(u, w):
    k, ch = w.shape
    pad = (k - 1) // 2
    return lax.conv_general_dilated(
        u, w[:, None, :].astype(u.dtype), window_strides=(1,), padding=[(pad, pad)],
        dimension_numbers=("NWC", "WIO", "NWC"), feature_group_count=ch)


def split_columns(p):
    idx = np.cumsum(np.array(SPLIT_SIZES))[:-1].tolist()
    return jnp.split(p, idx, axis=-1)


def setup_inputs(seed: int = 0) -> dict:
    key = jax.random.key(seed)
    ks = jax.random.split(key, 20)
    f32 = jnp.float32

    def nrm(k, shape, scale):
        return jax.random.normal(k, shape, f32) * scale

    L, D = DEPTH, D_MODEL
    return {
        "x": nrm(ks[0], (BATCH, SEQ, D), 1.0),
        "c": nrm(ks[1], (BATCH, D), 1.0),
        "norm_gain": 1.0 + nrm(ks[2], (L, D), 0.02),
        "w_ada": nrm(ks[3], (L, D, 3 * D), 0.5 * D ** -0.5),
        "b_ada": nrm(ks[4], (L, 3 * D), 0.02),
        "w_in": nrm(ks[5], (L, D, D_IN), D ** -0.5),
        "b_merge": nrm(ks[6], (L, 2 * D), 0.02),
        "conv_a_w": nrm(ks[7], (L, K_A, W_A), K_A ** -0.5),
        "w_out_a": nrm(ks[8], (L, W_A, D), W_A ** -0.5),
        "conv_b_w": nrm(ks[9], (L, K_B, W_B), K_B ** -0.5),
        "conv_b_bias": nrm(ks[10], (L, W_B), 0.02),
        "ln_b_gain": 1.0 + nrm(ks[11], (L, W_B), 0.02),
        "ln_b_bias": nrm(ks[12], (L, W_B), 0.02),
        "w_out_b": nrm(ks[13], (L, W_B, D), W_B ** -0.5),
        "b_out_b": nrm(ks[14], (L, D), 0.02),
        "w_o": nrm(ks[15], (L, D, D), D ** -0.5),
        "final_gain": 1.0 + nrm(ks[16], (D,), 0.02),
    }


def reference(x, c, norm_gain, w_ada, b_ada, w_in, b_merge, conv_a_w, w_out_a,
              conv_b_w, conv_b_bias, ln_b_gain, ln_b_bias, w_out_b, b_out_b, w_o,
              final_gain):
    c_act = jax.nn.silu(c)
    for l in range(DEPTH):
        mod = c_act @ w_ada[l] + b_ada[l]
        shift, scale, gate = jnp.split(mod, 3, axis=-1)
        h = rms_norm(x, norm_gain[l]) * (1.0 + scale[:, None, :]) + shift[:, None, :]

        proj = h @ w_in[l]
        b_a, c_a, v_a, z_a, a_b, g_b, z_b, m_a, m_b = split_columns(proj)
        bm_a, bm_b = jnp.split(b_merge[l], 2, axis=-1)

        y_a = b_a * depthwise_conv_centred(c_a * v_a, conv_a_w[l])
        y_a = (y_a * jax.nn.silu(z_a)) @ w_out_a[l]

        u_b = a_b * jax.nn.sigmoid(g_b)
        u_b = depthwise_conv_centred(u_b, conv_b_w[l]) + conv_b_bias[l]
        u_b = jax.nn.silu(layer_norm(u_b, ln_b_gain[l], ln_b_bias[l]))
        y_b = (u_b * jax.nn.silu(z_b)) @ w_out_b[l] + b_out_b[l]

        merged = jax.nn.sigmoid(m_a + bm_a) * y_a + jax.nn.sigmoid(m_b + bm_b) * y_b
        x = x + gate[:, None, :] * (merged @ w_o[l])
    return rms_norm(x, final_gain)
```

```cpp
#include <hip/hip_runtime.h>
#include <hip/hip_cooperative_groups.h>
#include <cstdio>
namespace cg = cooperative_groups;

#ifndef N_LAUNCHES
#define N_LAUNCHES 1
#endif

#define LAS __attribute__((address_space(3)))
typedef unsigned short bf16_t;
typedef short bf16x8 __attribute__((ext_vector_type(8)));
typedef float f32x4 __attribute__((ext_vector_type(4)));
typedef unsigned u32x4 __attribute__((ext_vector_type(4)));
typedef unsigned u32x2 __attribute__((ext_vector_type(2)));

constexpr int D = 1024, NBATCH = 8, SEQ = 4096, M = NBATCH * SEQ, DIN = 9216;
constexpr float EPS = 1e-6f;
constexpr int LDS_BYTES = 131072;

constexpr size_t WS_W1T = 0;
constexpr size_t WS_WAB = WS_W1T + (size_t)DIN * D * 2;
constexpr size_t WS_WOT = WS_WAB + (size_t)2 * D * D * 2;
constexpr size_t WS_MOD = WS_WOT + (size_t)D * D * 2;
constexpr size_t WS_ACT = WS_MOD + 131072;
constexpr size_t SLOT = (size_t)M * D * 2;
constexpr size_t WS_END = WS_ACT + 7 * SLOT;

__device__ __forceinline__ float bflo(unsigned u) { return __uint_as_float(u << 16); }
__device__ __forceinline__ float bfhi(unsigned u) { return __uint_as_float(u & 0xffff0000u); }
__device__ __forceinline__ unsigned cvt_pk_bf16(float lo, float hi) { unsigned r; asm("v_cvt_pk_bf16_f32 %0, %1, %2" : "=v"(r) : "v"(lo), "v"(hi)); return r; }
__device__ __forceinline__ float sigm(float x) { return __builtin_amdgcn_rcpf(1.0f + __builtin_amdgcn_exp2f(-1.44269504f * x)); }
__device__ __forceinline__ float silu(float x) { return x * sigm(x); }
__device__ __forceinline__ void unpack8(const u32x4 v, float (&f)[8]) {
    f[0] = bflo(v.x); f[1] = bfhi(v.x); f[2] = bflo(v.y); f[3] = bfhi(v.y); f[4] = bflo(v.z); f[5] = bfhi(v.z); f[6] = bflo(v.w); f[7] = bfhi(v.w);
}
__device__ __forceinline__ u32x4 pack8(const float (&f)[8]) {
    u32x4 o; o.x = cvt_pk_bf16(f[0], f[1]); o.y = cvt_pk_bf16(f[2], f[3]); o.z = cvt_pk_bf16(f[4], f[5]); o.w = cvt_pk_bf16(f[6], f[7]); return o;
}
__device__ __forceinline__ float wave_sum(float v) {
#pragma unroll
    for (int o = 1; o < 64; o <<= 1) v += __shfl_xor(v, o);
    return v;
}
__device__ __forceinline__ float half_sum(float v) {
#pragma unroll
    for (int o = 1; o < 32; o <<= 1) v += __shfl_xor(v, o);
    return v;
}

namespace pg8 {
constexpr int BM = 256, BK = 64, HALF = 128, HTB = HALF * BK * 2, STAGE_BYTES = 8 * HTB, NXCD = 8, WGM = 8;
__host__ __device__ __forceinline__ int lds_byte(int r, int c) { const int st = (r >> 4) * 2 + (c >> 5), rr = r & 15, cc = c & 31, ob = rr * 64 + cc * 2; return st * 1024 + (ob ^ (((ob >> 9) & 1) << 5)); }
__host__ __device__ __forceinline__ void stage_rc(int b, int& R, int& C) { const int st = b / 1024, sb = b % 1024, swz = sb ^ (((sb >> 9) & 1) << 5); R = (st >> 1) * 16 + swz / 64; C = (st & 1) * 32 + (swz % 64) / 2; }
__host__ __device__ __forceinline__ int perm32(int rho) { const int n = rho >> 4, i = rho & 15; return 8 * (i >> 2) + 4 * n + (i & 3); }

struct Unit { int pm, pn; };
struct Gemm { const bf16_t* A; const bf16_t* Bt; int M, N, K; };

struct StaticOrder {
    int nM, nN, nwg, G, c;
    __device__ void init(int M_, int N_, int G_, int c_) { nM = M_ / BM; nN = N_ / BM; nwg = nM * nN; G = G_; c = c_; }
    __device__ bool map(long L, Unit& u) const {
        if (L >= nwg) return false;
        int wgid = (int)L; { const int q = nwg / NXCD, r = nwg % NXCD, xcd = wgid % NXCD, off = wgid / NXCD; wgid = (xcd < r ? xcd * (q + 1) : r * (q + 1) + (xcd - r) * q) + off; }
        const int nig = WGM * nN, gid = wgid / nig, fm = gid * WGM, gsz = (nM - fm) < WGM ? (nM - fm) : WGM;
        u.pm = fm + ((wgid % nig) % gsz); u.pn = (wgid % nig) / gsz; return true;
    }
    __device__ bool next(int i, Unit& u) const { return map((long)i * G + c, u); }
    __device__ __forceinline__ void a_ready(const Unit&) const {}
    __device__ __forceinline__ void done(const Unit&) const {}
};
struct PairOrder : StaticOrder {
    __device__ bool next(int i, Unit& u) const {
        const int j = i >> 1, h = i & 1;
        if (!map((long)j * G + c, u)) return false;
        u.pm += h * nM; u.pn += h * nN; return true;
    }
};

template <class Epi, class Sched>
__device__ __forceinline__ void gemm_phase(LAS unsigned char* lds, const Gemm g, const Sched& S, const Epi& E) {
    const int tid = threadIdx.x, wid = __builtin_amdgcn_readfirstlane(tid >> 6), lane = tid & 63, wr = wid >> 2, wc = wid & 3, fr = lane & 15, fq = lane >> 4;
    const int K = g.K, nt = K / BK;
    unsigned voffA[2], voffB[2];
#pragma unroll
    for (int i = 0; i < 2; ++i) { int R, C; stage_rc(tid * 16 + i * 8192, R, C); const int Rb = Epi::PERM ? ((R & ~31) + perm32(R & 31)) : R;
        voffA[i] = (unsigned)(R * K + C) * 2u; voffB[i] = (unsigned)(Rb * K + C) * 2u; }
    const size_t kstep = (size_t)(BK * 2);
    const size_t hstep = (size_t)HALF * K * 2;
    const size_t tstep = 2 * hstep;
    const unsigned ldsw = (unsigned)wid * 1024u;
    const int aoff = lds_byte(wr * 64 + fr, fq * 8), boff = lds_byte(wc * 32 + fr, fq * 8);
#define PG8_SA(b, h) (((b) * 2 + (h)) * HTB)
#define PG8_SB(b, h) ((4 + (b) * 2 + (h)) * HTB)
#define PG8_STAGE(bufoff, gbase, voff) do { _Pragma("unroll") for (int _i = 0; _i < 2; ++_i) \
        __builtin_amdgcn_global_load_lds((const unsigned*)((const char*)(gbase) + (voff)[_i]), (LAS unsigned*)(lds + (bufoff) + ldsw + _i * 8192), 16, 0, 0); } while (0)
#define PG8_LDA(dst, b, h) do { _Pragma("unroll") for (int m = 0; m < 4; ++m) _Pragma("unroll") for (int k = 0; k < 2; ++k) dst[m][k] = *(const LAS bf16x8*)(lds + PG8_SA(b, h) + aoff + m * 2048 + k * 1024); } while (0)
#define PG8_LDB(dst, b, h) do { _Pragma("unroll") for (int n = 0; n < 2; ++n) _Pragma("unroll") for (int k = 0; k < 2; ++k) dst[n][k] = *(const LAS bf16x8*)(lds + PG8_SB(b, h) + boff + n * 2048 + k * 1024); } while (0)
#define PG8_MMA(ai, bj, At, Bt) do { __builtin_amdgcn_s_setprio(1); _Pragma("unroll") for (int m = 0; m < 4; ++m) _Pragma("unroll") for (int n = 0; n < 2; ++n) _Pragma("unroll") for (int k = 0; k < 2; ++k) \
        acc[ai][bj][m][n] = __builtin_amdgcn_mfma_f32_16x16x32_bf16(Bt[n][k], At[m][k], acc[ai][bj][m][n], 0, 0, 0); __builtin_amdgcn_s_setprio(0); } while (0)
#define PG8_WAIT_V(n) asm volatile("s_waitcnt vmcnt(" #n ")" ::: "memory")
#define PG8_WAIT_L(n) asm volatile("s_waitcnt lgkmcnt(" #n ")" ::: "memory")
#define PG8_BAR __builtin_amdgcn_s_barrier()
#define PG8_SCHED __builtin_amdgcn_sched_barrier(0)
    Unit cur, nxt; int ui = 0;
    if (!S.next(0, cur)) return;
    f32x4 acc[2][2][4][2];
#pragma unroll
    for (int a = 0; a < 2; ++a)
#pragma unroll
        for (int b = 0; b < 2; ++b)
#pragma unroll
            for (int m = 0; m < 4; ++m)
#pragma unroll
                for (int n = 0; n < 2; ++n) acc[a][b][m][n] = (f32x4){0.f, 0.f, 0.f, 0.f};
    bf16x8 At[4][2], B0[2][2], B1[2][2];
    const char* cA = (const char*)g.A + (size_t)cur.pm * tstep; const char* cB = (const char*)g.Bt + (size_t)cur.pn * tstep;
    S.a_ready(cur);
    PG8_STAGE(PG8_SB(0, 0), cB, voffB); PG8_STAGE(PG8_SA(0, 0), cA, voffA); PG8_STAGE(PG8_SB(0, 1), cB + hstep, voffB); PG8_STAGE(PG8_SA(0, 1), cA + hstep, voffA);
    if (wr == 1) PG8_BAR;
    PG8_WAIT_V(4); PG8_BAR;
    PG8_STAGE(PG8_SB(1, 0), cB + kstep, voffB); PG8_STAGE(PG8_SA(1, 0), cA + kstep, voffA); PG8_STAGE(PG8_SB(1, 1), cB + hstep + kstep, voffB);
    PG8_WAIT_V(6); PG8_BAR;
    for (;;) {
        const bool has_next = S.next(ui + 1, nxt);
        const char* nA = has_next ? (const char*)g.A + (size_t)nxt.pm * tstep : cA; const char* nB = has_next ? (const char*)g.Bt + (size_t)nxt.pn * tstep : cB;
        for (int t = 0; t < nt; t += 2) {
            const bool last = (t == nt - 2);
            const char* a1 = cA + (size_t)(t + 1) * kstep;
            const char* a2 = last ? nA : cA + (size_t)(t + 2) * kstep; const char* b2 = last ? nB : cB + (size_t)(t + 2) * kstep;
            const char* a3 = a2 + kstep; const char* b3 = b2 + kstep;
            if (last && has_next) S.a_ready(nxt);
            PG8_LDB(B0, 0, 0); PG8_SCHED; PG8_LDA(At, 0, 0); PG8_STAGE(PG8_SA(1, 1), a1 + hstep, voffA);
            PG8_WAIT_L(8); PG8_BAR; PG8_WAIT_L(0); PG8_MMA(0, 0, At, B0); PG8_BAR; PG8_SCHED;
            PG8_LDB(B1, 0, 1); PG8_STAGE(PG8_SB(0, 0), b2, voffB);
            PG8_BAR; PG8_WAIT_L(0); PG8_MMA(0, 1, At, B1); PG8_BAR;
            PG8_LDA(At, 0, 1); PG8_STAGE(PG8_SA(0, 0), a2, voffA);
            PG8_BAR; PG8_WAIT_L(0); PG8_MMA(1, 0, At, B0); PG8_BAR; PG8_SCHED;
            PG8_STAGE(PG8_SB(0, 1), b2 + hstep, voffB);
            PG8_WAIT_V(6); PG8_BAR; PG8_MMA(1, 1, At, B1); PG8_BAR;
            PG8_LDB(B0, 1, 0); PG8_SCHED; PG8_LDA(At, 1, 0); PG8_STAGE(PG8_SA(0, 1), a2 + hstep, voffA);
            PG8_WAIT_L(8); PG8_BAR; PG8_WAIT_L(0); PG8_MMA(0, 0, At, B0); PG8_BAR; PG8_SCHED;
            PG8_LDB(B1, 1, 1); PG8_STAGE(PG8_SB(1, 0), b3, voffB);
            PG8_BAR; PG8_WAIT_L(0); PG8_MMA(0, 1, At, B1); PG8_BAR;
            PG8_LDA(At, 1, 1); PG8_STAGE(PG8_SA(1, 0), a3, voffA);
            PG8_BAR; PG8_WAIT_L(0); PG8_MMA(1, 0, At, B0); PG8_BAR; PG8_SCHED;
            PG8_STAGE(PG8_SB(1, 1), b3 + hstep, voffB);
            PG8_WAIT_V(6); PG8_BAR; PG8_MMA(1, 1, At, B1); PG8_BAR;
        }
        E(acc, cur, wr, wc, fr, fq); S.done(cur);
        if (!has_next) break;
#pragma unroll
        for (int a = 0; a < 2; ++a)
#pragma unroll
            for (int b = 0; b < 2; ++b)
#pragma unroll
                for (int m = 0; m < 4; ++m)
#pragma unroll
                    for (int n = 0; n < 2; ++n) acc[a][b][m][n] = (f32x4){0.f, 0.f, 0.f, 0.f};
        cur = nxt; cA = nA; cB = nB; ++ui;
    }
    PG8_WAIT_V(0);
    if (wr == 0) PG8_BAR;
    PG8_BAR;
#undef PG8_SA
#undef PG8_SB
#undef PG8_STAGE
#undef PG8_LDA
#undef PG8_LDB
#undef PG8_MMA
#undef PG8_WAIT_V
#undef PG8_WAIT_L
#undef PG8_BAR
#undef PG8_SCHED
}
}


struct Epi1 {
    static constexpr bool PERM = true;
    bf16_t* act;
    template <int MODE> __device__ __forceinline__ void pair(const f32x4 (&acc)[2][2][4][2], bf16_t* O, int row0, int col0) const {
#pragma unroll
        for (int ai = 0; ai < 2; ++ai)
#pragma unroll
            for (int m = 0; m < 4; ++m) {
                float r[8];
#pragma unroll
                for (int n = 0; n < 2; ++n)
#pragma unroll
                    for (int j = 0; j < 4; ++j) { const float a = acc[ai][0][m][n][j], b = acc[ai][1][m][n][j];
                        r[4 * n + j] = MODE == 0 ? a * b : (MODE == 1 ? a * silu(b) : a * sigm(b)); }
                *(u32x4*)(O + (size_t)(row0 + ai * 128 + m * 16) * D + col0) = pack8(r);
            }
    }
    template <int MODE> __device__ __forceinline__ void single(const f32x4 (&acc)[2][2][4][2], bf16_t* O, int row0, int col0) const {
#pragma unroll
        for (int bj = 0; bj < 2; ++bj)
#pragma unroll
            for (int ai = 0; ai < 2; ++ai)
#pragma unroll
                for (int m = 0; m < 4; ++m) {
                    float r[8];
#pragma unroll
                    for (int j = 0; j < 4; ++j) { const float v0 = acc[ai][bj][m][0][j], v1 = acc[ai][bj][m][1][j];
                        r[j] = MODE == 0 ? silu(v0) : v0; r[4 + j] = MODE == 0 ? silu(v1) : v1; }
                    *(u32x4*)(O + (size_t)(row0 + ai * 128 + m * 16) * D + col0 + bj * 128) = pack8(r);
                }
    }
    __device__ __forceinline__ void operator()(const f32x4 (&acc)[2][2][4][2], const pg8::Unit& u, int wr, int wc, int fr, int fq) const {
        const int row0 = u.pm * 256 + wr * 64 + fr, tile = u.pn;
        if (tile < 24) {
            const int grp = tile >> 3, col0 = 128 * (tile & 7) + wc * 32 + 8 * fq;
            if (grp == 0) pair<0>(acc, act + 1 * (SLOT / 2), row0, col0);
            else if (grp == 1) pair<1>(acc, act + 2 * (SLOT / 2), row0, col0);
            else pair<2>(acc, act + 4 * (SLOT / 2), row0, col0);
        } else {
            const int t2 = tile - 24, g2 = t2 >> 2, col0 = 256 * (t2 & 3) + wc * 32 + 8 * fq;
            if (g2 == 0) single<0>(acc, act + 3 * (SLOT / 2), row0, col0);
            else single<1>(acc, act + (4 + g2) * (SLOT / 2), row0, col0);
        }
    }
};

struct EpiY {
    static constexpr bool PERM = true;
    bf16_t* Y;
    __device__ __forceinline__ void operator()(const f32x4 (&acc)[2][2][4][2], const pg8::Unit& u, int wr, int wc, int fr, int fq) const {
        const int row0 = u.pm * 256 + wr * 64 + fr, col0 = (u.pn & 3) * 256 + wc * 32 + 8 * fq;
#pragma unroll
        for (int bj = 0; bj < 2; ++bj)
#pragma unroll
            for (int ai = 0; ai < 2; ++ai)
#pragma unroll
                for (int m = 0; m < 4; ++m) {
                    float r[8];
#pragma unroll
                    for (int j = 0; j < 4; ++j) { r[j] = acc[ai][bj][m][0][j]; r[4 + j] = acc[ai][bj][m][1][j]; }
                    *(u32x4*)(Y + (size_t)(row0 + ai * 128 + m * 16) * D + col0 + bj * 128) = pack8(r);
                }
    }
};
struct EpiF {
    static constexpr bool PERM = false;
    float* out;
    __device__ __forceinline__ void operator()(const f32x4 (&acc)[2][2][4][2], const pg8::Unit& u, int wr, int wc, int fr, int fq) const {
        const int row0 = u.pm * 256 + wr * 64 + fr, col0 = u.pn * 256 + wc * 32 + 4 * fq;
#pragma unroll
        for (int ai = 0; ai < 2; ++ai)
#pragma unroll
            for (int m = 0; m < 4; ++m) { float* rowp = out + (size_t)(row0 + ai * 128 + m * 16) * D + col0;
#pragma unroll
                for (int bj = 0; bj < 2; ++bj)
#pragma unroll
                    for (int n = 0; n < 2; ++n) *(f32x4*)(rowp + bj * 128 + n * 16) = acc[ai][bj][m][n]; }
    }
};

__device__ __forceinline__ int w1_srccol(int nc) {
    const int tile = nc >> 8, within = nc & 255;
    if (tile < 24) { const int grp = tile >> 3, half = within >> 7, ch = 128 * (tile & 7) + (within & 127);
        const int split = grp == 0 ? (half ? 2 : 1) : (grp == 1 ? (half ? 3 : 0) : (half ? 5 : 4));
        return split * 1024 + ch; }
    const int t2 = tile - 24;
    return (6 + (t2 >> 2)) * 1024 + 256 * (t2 & 3) + within;
}
__device__ __forceinline__ void transpose_item(const float* W, int ldw, int srccol0, bf16_t* WT, int row0, int k0, LAS float* scr, int lane) {
#pragma unroll 8
    for (int i = 0; i < 32; ++i) { const int kk = 2 * i + (lane >> 5); scr[kk * 33 + (lane & 31)] = W[(size_t)(k0 + kk) * ldw + srccol0 + (lane & 31)]; }
    asm volatile("s_waitcnt lgkmcnt(0)" ::: "memory");
    const int c = lane & 7;
#pragma unroll
    for (int j = 0; j < 4; ++j) { const int n = (lane >> 3) + 8 * j; const LAS float* s = scr + (8 * c) * 33 + n;
        u32x4 o; o.x = cvt_pk_bf16(s[0 * 33], s[1 * 33]); o.y = cvt_pk_bf16(s[2 * 33], s[3 * 33]); o.z = cvt_pk_bf16(s[4 * 33], s[5 * 33]); o.w = cvt_pk_bf16(s[6 * 33], s[7 * 33]);
        *(u32x4*)(WT + (size_t)(row0 + n) * D + k0 + 8 * c) = o; }
    asm volatile("s_waitcnt lgkmcnt(0)" ::: "memory");
}
__device__ __forceinline__ void p0_phase(LAS unsigned char* lds, const float* c, const float* w_ada, const float* b_ada, const float* w_in, const float* w_out_a, const float* w_out_b,
                                         const float* w_o, unsigned char* ws, int G) {
    const int tid = threadIdx.x, lane = tid & 63, wave = tid >> 6;
    float* mod = (float*)(ws + WS_MOD);
    for (int item = blockIdx.x; item < 192; item += G) {
        LAS float* cact = (LAS float*)lds;
        LAS float* red = (LAS float*)(lds + 32768);
        for (int i = tid; i < NBATCH * D; i += 512) cact[i] = silu(c[i]);
        __syncthreads();
        const int col = tid & 15, kg = tid >> 4, j = item * 16 + col;
        float a[8];
#pragma unroll
        for (int b = 0; b < 8; ++b) a[b] = 0.f;
#pragma unroll 8
        for (int kk = 0; kk < 32; ++kk) { const int k = kg * 32 + kk; const float w = w_ada[(size_t)k * (3 * D) + j];
#pragma unroll
            for (int b = 0; b < 8; ++b) a[b] = fmaf(cact[b * D + k], w, a[b]); }
#pragma unroll
        for (int b = 0; b < 8; ++b) red[(b * 16 + col) * 33 + kg] = a[b];
        __syncthreads();
        if (tid < 128) { const int b = tid >> 4, cl = tid & 15; float s = 0.f;
            for (int q = 0; q < 32; ++q) s += red[(b * 16 + cl) * 33 + q];
            mod[b * 3 * D + item * 16 + cl] = s + b_ada[item * 16 + cl]; }
        __syncthreads();
    }
    LAS float* scr = (LAS float*)(lds + wave * 8448);
    const int gw = blockIdx.x * 8 + wave, NGW = G * 8;
    bf16_t* W1T = (bf16_t*)(ws + WS_W1T); bf16_t* WAB = (bf16_t*)(ws + WS_WAB); bf16_t* WOT = (bf16_t*)(ws + WS_WOT);
    constexpr int I1 = 16 * (DIN / 32), I2 = 16 * (D / 32);
    for (int it = gw; it < I1 + 3 * I2; it += NGW) {
        int r = it;
        if (r < I1) { const int kb = r / (DIN / 32), nb = r % (DIN / 32); transpose_item(w_in, DIN, w1_srccol(nb * 32), W1T, nb * 32, kb * 64, scr, lane); continue; }
        r -= I1;
        const int which = r / I2; r -= which * I2;
        const int kb = r / (D / 32), nb = r % (D / 32);
        if (which == 0) transpose_item(w_out_a, D, nb * 32, WAB, nb * 32, kb * 64, scr, lane);
        else if (which == 1) transpose_item(w_out_b, D, nb * 32, WAB, D + nb * 32, kb * 64, scr, lane);
        else transpose_item(w_o, D, nb * 32, WOT, nb * 32, kb * 64, scr, lane);
    }
}

__device__ __forceinline__ void p1_phase(const float* x, const float* gain, const float* mod, bf16_t* H, int G) {
    const int lane = threadIdx.x & 63, gw = blockIdx.x * 8 + (threadIdx.x >> 6), NGW = G * 8;
    for (int row = gw; row < M; row += NGW) {
        const f32x4* xr = (const f32x4*)(x + (size_t)row * D) + lane;
        f32x4 v[4]; float ss = 0.f;
#pragma unroll
        for (int j = 0; j < 4; ++j) { v[j] = xr[64 * j]; ss += (v[j].x * v[j].x + v[j].y * v[j].y) + (v[j].z * v[j].z + v[j].w * v[j].w); }
        const float r = rsqrtf(wave_sum(ss) * (1.f / D) + EPS);
        const float* shift = mod + (size_t)(row >> 12) * 3 * D; const float* scale = shift + D;
#pragma unroll
        for (int j = 0; j < 4; ++j) { const int cidx = 4 * lane + 256 * j;
            const f32x4 g = *(const f32x4*)(gain + cidx), sc = *(const f32x4*)(scale + cidx), sh = *(const f32x4*)(shift + cidx);
            const f32x4 h = (v[j] * r) * g * (1.0f + sc) + sh;
            u32x2 o; o.x = cvt_pk_bf16(h.x, h.y); o.y = cvt_pk_bf16(h.z, h.w);
            *(u32x2*)(H + (size_t)row * D + cidx) = o; }
    }
}

__device__ __forceinline__ void p3a_phase(const bf16_t* CV, bf16_t* BZ, const float* wa, int G) {
    const int gt = blockIdx.x * 512 + threadIdx.x, NT = G * 512;
    for (int item = gt; item < (M / 4) * (D / 8); item += NT) {
        const int tq = item >> 7, cb = (item & 127) * 8, t0 = tq * 4, p0 = t0 & (SEQ - 1);
        float w0[8], w1[8], w2[8];
        { const f32x4 a = *(const f32x4*)(wa + cb), b = *(const f32x4*)(wa + cb + 4), c2 = *(const f32x4*)(wa + D + cb), d = *(const f32x4*)(wa + D + cb + 4),
              e2 = *(const f32x4*)(wa + 2 * D + cb), f = *(const f32x4*)(wa + 2 * D + cb + 4);
#pragma unroll
          for (int e = 0; e < 4; ++e) { w0[e] = a[e]; w0[4 + e] = b[e]; w1[e] = c2[e]; w1[4 + e] = d[e]; w2[e] = e2[e]; w2[4 + e] = f[e]; } }
        u32x4 rows[6], bzr[4];
#pragma unroll
        for (int i = 0; i < 6; ++i) { const int pos = p0 - 1 + i; rows[i] = (u32x4){0u, 0u, 0u, 0u};
            if (pos >= 0 && pos < SEQ) rows[i] = *(const u32x4*)(CV + (size_t)(t0 - 1 + i) * D + cb); }
#pragma unroll
        for (int j = 0; j < 4; ++j) bzr[j] = *(const u32x4*)(BZ + (size_t)(t0 + j) * D + cb);
#pragma unroll
        for (int j = 0; j < 4; ++j) { float a[8], b[8], c[8], bz[8], r[8];
            unpack8(rows[j], a); unpack8(rows[j + 1], b); unpack8(rows[j + 2], c); unpack8(bzr[j], bz);
#pragma unroll
            for (int e = 0; e < 8; ++e) r[e] = bz[e] * (w0[e] * a[e] + w1[e] * b[e] + w2[e] * c[e]);
            *(u32x4*)(BZ + (size_t)(t0 + j) * D + cb) = pack8(r); }
    }
}
__device__ __forceinline__ void p3b_phase(LAS unsigned char* lds, bf16_t* SZ, const bf16_t* U, const float* wb, const float* cbias, const float* lng, const float* lnb, int G) {
    const int tid = threadIdx.x, co = tid & 31, tg = tid >> 5;
    LAS unsigned char* ut = lds;
    LAS unsigned char* wt = lds + 49152;
    for (int tile = blockIdx.x; tile < M / 64; tile += G) {
        const int t0 = tile * 64, p0 = t0 & (SEQ - 1);
        u32x4 pk[4][4];
        float s1[4], s2[4];
#pragma unroll
        for (int j = 0; j < 4; ++j) { s1[j] = 0.f; s2[j] = 0.f; }
#pragma unroll
        for (int ch = 0; ch < 4; ++ch) {
            __syncthreads();
            int c0 = ch * 256; asm volatile("" : "+s"(c0) :: "memory");
            const int cb = c0 + co * 8;
            {   const bf16_t* ug = U + (size_t)(t0 - 15 + tg) * D + c0 + co * 8; LAS unsigned char* ul = ut + tg * 512 + co * 16;
#pragma unroll
                for (int it = 0; it < 6; ++it) { const int r = it * 16 + tg, pos = p0 - 15 + r;
                    if (it < 5 || tg < 14) { u32x4 v = (u32x4){0u, 0u, 0u, 0u};
                        if (pos >= 0 && pos < SEQ) v = *(const u32x4*)(ug + (size_t)it * 16 * D);
                        *(LAS u32x4*)(ul + it * 8192) = v; } }
                const int wv = tid >> 6, cc = tid & 63;
                const float* wg = wb + (size_t)wv * D + c0 + cc * 4; LAS unsigned char* wl = wt + ((wv * 2 + (cc & 1)) * 32 + (cc >> 1)) * 16;
#pragma unroll
                for (int it = 0; it < 4; ++it) { if (it < 3 || wv < 7) *(LAS f32x4*)(wl + it * 8192) = *(const f32x4*)(wg + (size_t)it * 8 * D); } }
            __syncthreads();
            float acc[4][8];
            {   const f32x4 b0 = *(const f32x4*)(cbias + cb), b1 = *(const f32x4*)(cbias + cb + 4);
#pragma unroll
                for (int j = 0; j < 4; ++j)
#pragma unroll
                    for (int e = 0; e < 4; ++e) { acc[j][e] = b0[e]; acc[j][4 + e] = b1[e]; } }
            const LAS unsigned char* ub = ut + (tg * 4) * 512 + co * 16;
            const LAS unsigned char* wp = wt + co * 16;
#pragma unroll 1
            for (int k = 0; k < 30; k += 2) {
                float ur[5][8];
#pragma unroll
                for (int i = 0; i < 5; ++i) unpack8(*(const LAS u32x4*)(ub + (k + i) * 512), ur[i]);
                const f32x4 wa0 = *(const LAS f32x4*)(wp + k * 1024), wa1 = *(const LAS f32x4*)(wp + k * 1024 + 512);
                const f32x4 wb0 = *(const LAS f32x4*)(wp + k * 1024 + 1024), wb1 = *(const LAS f32x4*)(wp + k * 1024 + 1536);
#pragma unroll
                for (int j = 0; j < 4; ++j)
#pragma unroll
                    for (int e = 0; e < 4; ++e) {
                        acc[j][e] = fmaf(wb0[e], ur[j + 1][e], fmaf(wa0[e], ur[j][e], acc[j][e]));
                        acc[j][4 + e] = fmaf(wb1[e], ur[j + 1][4 + e], fmaf(wa1[e], ur[j][4 + e], acc[j][4 + e])); }
            }
            {   float ur[4][8];
#pragma unroll
                for (int i = 0; i < 4; ++i) unpack8(*(const LAS u32x4*)(ub + (30 + i) * 512), ur[i]);
                const f32x4 wa0 = *(const LAS f32x4*)(wp + 30 * 1024), wa1 = *(const LAS f32x4*)(wp + 30 * 1024 + 512);
#pragma unroll
                for (int j = 0; j < 4; ++j)
#pragma unroll
                    for (int e = 0; e < 4; ++e) { acc[j][e] = fmaf(wa0[e], ur[j][e], acc[j][e]); acc[j][4 + e] = fmaf(wa1[e], ur[j][4 + e], acc[j][4 + e]); }
            }
#pragma unroll
            for (int j = 0; j < 4; ++j) {
#pragma unroll
                for (int e = 0; e < 8; ++e) { s1[j] += acc[j][e]; s2[j] = fmaf(acc[j][e], acc[j][e], s2[j]); }
                pk[ch][j] = pack8(acc[j]); }
        }
        float mean[4], rstd[4];
#pragma unroll
        for (int j = 0; j < 4; ++j) { mean[j] = half_sum(s1[j]) * (1.f / D); const float ex2 = half_sum(s2[j]) * (1.f / D);
            rstd[j] = rsqrtf(fmaxf(ex2 - mean[j] * mean[j], 0.f) + EPS); }
#pragma unroll
        for (int ch = 0; ch < 4; ++ch) { int c0 = ch * 256; asm volatile("" : "+s"(c0) :: "memory"); const int cb = c0 + co * 8;
            float g[8], b[8];
            { const f32x4 g0 = *(const f32x4*)(lng + cb), g1 = *(const f32x4*)(lng + cb + 4), b0 = *(const f32x4*)(lnb + cb), b1 = *(const f32x4*)(lnb + cb + 4);
#pragma unroll
              for (int e = 0; e < 4; ++e) { g[e] = g0[e]; g[4 + e] = g1[e]; b[e] = b0[e]; b[4 + e] = b1[e]; } }
#pragma unroll
            for (int j = 0; j < 4; ++j) { const size_t off = (size_t)(t0 + tg * 4 + j) * D + cb;
                float sz[8], v[8], r[8]; unpack8(*(const u32x4*)(SZ + off), sz); unpack8(pk[ch][j], v);
#pragma unroll
                for (int e = 0; e < 8; ++e) { const float y = (v[e] - mean[j]) * rstd[j] * g[e] + b[e]; r[e] = silu(y) * sz[e]; }
                *(u32x4*)(SZ + off) = pack8(r); } }
    }
}

__device__ __forceinline__ void merge_phase(const bf16_t* MA, const bf16_t* MB, const bf16_t* YA, const bf16_t* YB, bf16_t* MG, const float* bmerge, const float* bob, int G) {
    const int gt = blockIdx.x * 512 + threadIdx.x, NT = G * 512;
    const int cb = (gt & 127) * 8;
    float ba[8], bb[8], bo[8];
    { const f32x4 a0 = *(const f32x4*)(bmerge + cb), a1 = *(const f32x4*)(bmerge + cb + 4), b0 = *(const f32x4*)(bmerge + D + cb), b1 = *(const f32x4*)(bmerge + D + cb + 4),
          c0 = *(const f32x4*)(bob + cb), c1 = *(const f32x4*)(bob + cb + 4);
#pragma unroll
      for (int e = 0; e < 4; ++e) { ba[e] = a0[e]; ba[4 + e] = a1[e]; bb[e] = b0[e]; bb[4 + e] = b1[e]; bo[e] = c0[e]; bo[4 + e] = c1[e]; } }
    for (size_t i = gt; i < (size_t)M * D / 8; i += NT) {
        float ma[8], mb[8], ya[8], yb[8], r[8];
        unpack8(*(const u32x4*)(MA + i * 8), ma); unpack8(*(const u32x4*)(MB + i * 8), mb); unpack8(*(const u32x4*)(YA + i * 8), ya); unpack8(*(const u32x4*)(YB + i * 8), yb);
#pragma unroll
        for (int e = 0; e < 8; ++e) r[e] = sigm(ma[e] + ba[e]) * ya[e] + sigm(mb[e] + bb[e]) * (yb[e] + bo[e]);
        *(u32x4*)(MG + i * 8) = pack8(r);
    }
}

__device__ __forceinline__ void p7_phase(float* out, const float* x, const float* mod, const float* fgain, int G) {
    const int lane = threadIdx.x & 63, gw = blockIdx.x * 8 + (threadIdx.x >> 6), NGW = G * 8;
    f32x4 g[4];
#pragma unroll
    for (int j = 0; j < 4; ++j) g[j] = *(const f32x4*)(fgain + 4 * lane + 256 * j);
    for (int row = gw; row < M; row += NGW) {
        f32x4* yr = (f32x4*)(out + (size_t)row * D) + lane; const f32x4* xr = (const f32x4*)(x + (size_t)row * D) + lane;
        const f32x4* gt = (const f32x4*)(mod + (size_t)(row >> 12) * 3 * D + 2 * D) + lane;
        f32x4 v[4]; float ss = 0.f;
#pragma unroll
        for (int j = 0; j < 4; ++j) { v[j] = xr[64 * j] + gt[64 * j] * yr[64 * j]; ss += (v[j].x * v[j].x + v[j].y * v[j].y) + (v[j].z * v[j].z + v[j].w * v[j].w); }
        const float r = rsqrtf(wave_sum(ss) * (1.f / D) + EPS);
#pragma unroll
        for (int j = 0; j < 4; ++j) yr[64 * j] = (v[j] * r) * g[j];
    }
}

struct Args { const float* in[17]; float* out; unsigned char* ws; int ph_lo, ph_hi; };

__global__ void __launch_bounds__(512, 2) fwd_kernel(Args a) {
    extern __shared__ __attribute__((aligned(16))) unsigned char shm[];
    LAS unsigned char* lds = (LAS unsigned char*)shm;
    cg::grid_group grid = cg::this_grid();
    const int G = gridDim.x, lo = a.ph_lo, hi = a.ph_hi;
    unsigned char* ws = a.ws;
    bf16_t* act = (bf16_t*)(ws + WS_ACT);
    const float* mod = (const float*)(ws + WS_MOD);
#define IN(k) (lo <= (k) && (k) < hi)
#define SEAM(k) do { if (IN(k) && IN((k) + 1)) grid.sync(); } while (0)
    if (IN(0)) p0_phase(lds, a.in[1], a.in[3], a.in[4], a.in[5], a.in[8], a.in[13], a.in[15], ws, G);
    SEAM(0);
    if (IN(1)) p1_phase(a.in[0], a.in[2], mod, act, G);
    SEAM(1);
    if (IN(2)) { pg8::Gemm g{act, (const bf16_t*)(ws + WS_W1T), M, DIN, D}; pg8::StaticOrder S; S.init(M, DIN, G, (int)blockIdx.x);
        Epi1 E{act}; pg8::gemm_phase<Epi1, pg8::StaticOrder>(lds, g, S, E); }
    SEAM(2);
    if (IN(3)) { p3a_phase(act + 1 * (SLOT / 2), act + 2 * (SLOT / 2), a.in[7], G);
        p3b_phase(lds, act + 3 * (SLOT / 2), act + 4 * (SLOT / 2), a.in[9], a.in[10], a.in[11], a.in[12], G); }
    SEAM(3);
    if (IN(4)) { pg8::Gemm g{act + 2 * (SLOT / 2), (const bf16_t*)(ws + WS_WAB), M, D, D}; pg8::PairOrder S; S.init(M, D, G, (int)blockIdx.x);
        EpiY E{act}; pg8::gemm_phase<EpiY, pg8::PairOrder>(lds, g, S, E); }
    SEAM(4);
    if (IN(5)) merge_phase(act + 5 * (SLOT / 2), act + 6 * (SLOT / 2), act, act + 1 * (SLOT / 2), act + 4 * (SLOT / 2), a.in[6], a.in[14], G);
    SEAM(5);
    if (IN(6)) { pg8::Gemm g{act + 4 * (SLOT / 2), (const bf16_t*)(ws + WS_WOT), M, D, D}; pg8::StaticOrder S; S.init(M, D, G, (int)blockIdx.x);
        EpiF E{a.out}; pg8::gemm_phase<EpiF, pg8::StaticOrder>(lds, g, S, E); }
    SEAM(6);
    if (IN(7)) p7_phase(a.out, a.in[0], mod, a.in[16], G);
#undef IN
#undef SEAM
}

extern "C" void kernel_launch(void* const* d_in, const int* in_sizes, int n_in, void* d_out, int out_size, void* d_ws, size_t ws_size, hipStream_t stream) {
    static int grid = 0;
    if (grid == 0) {
        if (n_in != 17 || out_size != M * D || ws_size < WS_END) { fprintf(stderr, "kernel_launch: unexpected shapes (n_in %d out %d ws %zu, need %zu)\n", n_in, out_size, ws_size, (size_t)WS_END); grid = -1; return; }
        int dev = 0, cus = 0, per_cu = 0;
        (void)hipGetDevice(&dev); (void)hipDeviceGetAttribute(&cus, hipDeviceAttributeMultiprocessorCount, dev);
        if (hipFuncSetAttribute((const void*)fwd_kernel, hipFuncAttributeMaxDynamicSharedMemorySize, LDS_BYTES) != hipSuccess) { fprintf(stderr, "kernel_launch: hipFuncSetAttribute failed\n"); grid = -1; return; }
        if (hipOccupancyMaxActiveBlocksPerMultiprocessor(&per_cu, (const void*)fwd_kernel, 512, LDS_BYTES) != hipSuccess || per_cu < 1) { fprintf(stderr, "kernel_launch: occupancy query says %d\n", per_cu); per_cu = 1; }
        (void)hipGetLastError();
        grid = cus;
    }
    if (grid < 0) return;
    Args a{};
    for (int i = 0; i < 17; ++i) a.in[i] = (const float*)d_in[i];
    a.out = (float*)d_out; a.ws = (unsigned char*)d_ws;
#if N_LAUNCHES == 1
    a.ph_lo = 0; a.ph_hi = 8;
    void* args[] = {&a};
    hipError_t e = hipLaunchCooperativeKernel((const void*)fwd_kernel, dim3(grid), dim3(512), args, LDS_BYTES, stream);
    if (e != hipSuccess) fprintf(stderr, "cooperative launch failed: %s (grid %d)\n", hipGetErrorString(e), grid);
#else
    for (int ph = 0; ph < 8; ++ph) { a.ph_lo = ph; a.ph_hi = ph + 1; hipLaunchKernelGGL(fwd_kernel, dim3(grid), dim3(512), LDS_BYTES, stream, a); }
#endif
}
```

```cpp
#include <hip/hip_runtime.h>
#include <hip/hip_cooperative_groups.h>
#include <cstdio>
namespace cg = cooperative_groups;

#ifndef N_LAUNCHES
#define N_LAUNCHES 1
#endif

#define LAS __attribute__((address_space(3)))
typedef unsigned short bf16_t;
typedef short bf16x8 __attribute__((ext_vector_type(8)));
typedef float f32x4 __attribute__((ext_vector_type(4)));
typedef unsigned u32x4 __attribute__((ext_vector_type(4)));
typedef unsigned u32x2 __attribute__((ext_vector_type(2)));

constexpr int D = 1024, NBATCH = 8, SEQ = 4096, M = NBATCH * SEQ, DIN = 9216;
constexpr float EPS = 1e-6f;
constexpr int LDS_BYTES = 131072 + 16;

constexpr size_t WS_W1T = 0;
constexpr size_t WS_WAB = WS_W1T + (size_t)DIN * D * 2;
constexpr size_t WS_WOT = WS_WAB + (size_t)2 * D * D * 2;
constexpr size_t WS_MOD = WS_WOT + (size_t)D * D * 2;
constexpr size_t WS_BAR = WS_MOD + 98304;
constexpr size_t WS_ACT = WS_MOD + 131072;
constexpr size_t SLOT = (size_t)M * D * 2;
constexpr size_t WS_END = WS_ACT + 7 * SLOT;

__device__ __forceinline__ float bflo(unsigned u) { return __uint_as_float(u << 16); }
__device__ __forceinline__ float bfhi(unsigned u) { return __uint_as_float(u & 0xffff0000u); }
__device__ __forceinline__ unsigned cvt_pk_bf16(float lo, float hi) { unsigned r; asm("v_cvt_pk_bf16_f32 %0, %1, %2" : "=v"(r) : "v"(lo), "v"(hi)); return r; }
__device__ __forceinline__ float sigm(float x) { return __builtin_amdgcn_rcpf(1.0f + __builtin_amdgcn_exp2f(-1.44269504f * x)); }
__device__ __forceinline__ float silu(float x) { return x * sigm(x); }
__device__ __forceinline__ void unpack8(const u32x4 v, float (&f)[8]) {
    f[0] = bflo(v.x); f[1] = bfhi(v.x); f[2] = bflo(v.y); f[3] = bfhi(v.y); f[4] = bflo(v.z); f[5] = bfhi(v.z); f[6] = bflo(v.w); f[7] = bfhi(v.w);
}
__device__ __forceinline__ u32x4 pack8(const float (&f)[8]) {
    u32x4 o; o.x = cvt_pk_bf16(f[0], f[1]); o.y = cvt_pk_bf16(f[2], f[3]); o.z = cvt_pk_bf16(f[4], f[5]); o.w = cvt_pk_bf16(f[6], f[7]); return o;
}
__device__ __forceinline__ float wave_sum(float v) {
#pragma unroll
    for (int o = 1; o < 64; o <<= 1) v += __shfl_xor(v, o);
    return v;
}
__device__ __forceinline__ float half_sum(float v) {
#pragma unroll
    for (int o = 1; o < 32; o <<= 1) v += __shfl_xor(v, o);
    return v;
}

namespace pg8 {
constexpr int BM = 256, BK = 64, HALF = 128, HTB = HALF * BK * 2, STAGE_BYTES = 8 * HTB, NXCD = 8, WGM = 8;
__host__ __device__ __forceinline__ int lds_byte(int r, int c) { const int st = (r >> 4) * 2 + (c >> 5), rr = r & 15, cc = c & 31, ob = rr * 64 + cc * 2; return st * 1024 + (ob ^ (((ob >> 9) & 1) << 5)); }
__host__ __device__ __forceinline__ void stage_rc(int b, int& R, int& C) { const int st = b / 1024, sb = b % 1024, swz = sb ^ (((sb >> 9) & 1) << 5); R = (st >> 1) * 16 + swz / 64; C = (st & 1) * 32 + (swz % 64) / 2; }
__host__ __device__ __forceinline__ int perm32(int rho) { const int n = rho >> 4, i = rho & 15; return 8 * (i >> 2) + 4 * n + (i & 3); }

struct Unit { int pm, pn; };
struct Gemm { const bf16_t* A; const bf16_t* Bt; int M, N, K; };

struct StaticOrder {
    int nM, nN, nwg, G, c;
    __device__ void init(int M_, int N_, int G_, int c_) { nM = M_ / BM; nN = N_ / BM; nwg = nM * nN; G = G_; c = c_; }
    __device__ bool map(long L, Unit& u) const {
        if (L >= nwg) return false;
        int wgid = (int)L; { const int q = nwg / NXCD, r = nwg % NXCD, xcd = wgid % NXCD, off = wgid / NXCD; wgid = (xcd < r ? xcd * (q + 1) : r * (q + 1) + (xcd - r) * q) + off; }
        const int nig = WGM * nN, gid = wgid / nig, fm = gid * WGM, gsz = (nM - fm) < WGM ? (nM - fm) : WGM;
        u.pm = fm + ((wgid % nig) % gsz); u.pn = (wgid % nig) / gsz; return true;
    }
    __device__ bool next(int i, Unit& u) const { return map((long)i * G + c, u); }
    __device__ __forceinline__ void a_ready(const Unit&) const {}
    __device__ __forceinline__ void done(const Unit&) const {}
};
struct PairOrder : StaticOrder {
    __device__ bool next(int i, Unit& u) const {
        const int j = i >> 1, h = i & 1;
        if (!map((long)j * G + c, u)) return false;
        u.pm += h * nM; u.pn += h * nN; return true;
    }
};

template <class Epi, class Sched>
__device__ __forceinline__ void gemm_phase(LAS unsigned char* lds, const Gemm g, const Sched& S, const Epi& E) {
    const int tid = threadIdx.x, wid = __builtin_amdgcn_readfirstlane(tid >> 6), lane = tid & 63, wr = wid >> 2, wc = wid & 3, fr = lane & 15, fq = lane >> 4;
    const int K = g.K, nt = K / BK;
    unsigned voffA[2], voffB[2];
#pragma unroll
    for (int i = 0; i < 2; ++i) { int R, C; stage_rc(tid * 16 + i * 8192, R, C); const int Rb = Epi::PERM ? ((R & ~31) + perm32(R & 31)) : R;
        voffA[i] = (unsigned)(R * K + C) * 2u; voffB[i] = (unsigned)(Rb * K + C) * 2u; }
    const size_t kstep = (size_t)(BK * 2);
    const size_t hstep = (size_t)HALF * K * 2;
    const size_t tstep = 2 * hstep;
    const unsigned ldsw = (unsigned)wid * 1024u;
    const int aoff = lds_byte(wr * 64 + fr, fq * 8), boff = lds_byte(wc * 32 + fr, fq * 8);
#define PG8_SA(b, h) (((b) * 2 + (h)) * HTB)
#define PG8_SB(b, h) ((4 + (b) * 2 + (h)) * HTB)
#define PG8_STAGE(bufoff, gbase, voff) do { _Pragma("unroll") for (int _i = 0; _i < 2; ++_i) \
        __builtin_amdgcn_global_load_lds((const unsigned*)((const char*)(gbase) + (voff)[_i]), (LAS unsigned*)(lds + (bufoff) + ldsw + _i * 8192), 16, 0, 0); } while (0)
#define PG8_LDA(dst, b, h) do { _Pragma("unroll") for (int m = 0; m < 4; ++m) _Pragma("unroll") for (int k = 0; k < 2; ++k) dst[m][k] = *(const LAS bf16x8*)(lds + PG8_SA(b, h) + aoff + m * 2048 + k * 1024); } while (0)
#define PG8_LDB(dst, b, h) do { _Pragma("unroll") for (int n = 0; n < 2; ++n) _Pragma("unroll") for (int k = 0; k < 2; ++k) dst[n][k] = *(const LAS bf16x8*)(lds + PG8_SB(b, h) + boff + n * 2048 + k * 1024); } while (0)
#define PG8_MMA(ai, bj, At, Bt) do { __builtin_amdgcn_s_setprio(1); _Pragma("unroll") for (int m = 0; m < 4; ++m) _Pragma("unroll") for (int n = 0; n < 2; ++n) _Pragma("unroll") for (int k = 0; k < 2; ++k) \
        acc[ai][bj][m][n] = __builtin_amdgcn_mfma_f32_16x16x32_bf16(Bt[n][k], At[m][k], acc[ai][bj][m][n], 0, 0, 0); __builtin_amdgcn_s_setprio(0); } while (0)
#define PG8_WAIT_V(n) asm volatile("s_waitcnt vmcnt(" #n ")" ::: "memory")
#define PG8_WAIT_L(n) asm volatile("s_waitcnt lgkmcnt(" #n ")" ::: "memory")
#define PG8_BAR __builtin_amdgcn_s_barrier()
#define PG8_SCHED __builtin_amdgcn_sched_barrier(0)
    Unit cur, nxt; int ui = 0;
    if (!S.next(0, cur)) return;
    f32x4 acc[2][2][4][2];
#pragma unroll
    for (int a = 0; a < 2; ++a)
#pragma unroll
        for (int b = 0; b < 2; ++b)
#pragma unroll
            for (int m = 0; m < 4; ++m)
#pragma unroll
                for (int n = 0; n < 2; ++n) acc[a][b][m][n] = (f32x4){0.f, 0.f, 0.f, 0.f};
    bf16x8 At[4][2], B0[2][2], B1[2][2];
    const char* cA = (const char*)g.A + (size_t)cur.pm * tstep; const char* cB = (const char*)g.Bt + (size_t)cur.pn * tstep;
    S.a_ready(cur);
    PG8_STAGE(PG8_SB(0, 0), cB, voffB); PG8_STAGE(PG8_SA(0, 0), cA, voffA); PG8_STAGE(PG8_SB(0, 1), cB + hstep, voffB); PG8_STAGE(PG8_SA(0, 1), cA + hstep, voffA);
    if (wr == 1) PG8_BAR;
    PG8_WAIT_V(4); PG8_BAR;
    PG8_STAGE(PG8_SB(1, 0), cB + kstep, voffB); PG8_STAGE(PG8_SA(1, 0), cA + kstep, voffA); PG8_STAGE(PG8_SB(1, 1), cB + hstep + kstep, voffB);
    PG8_WAIT_V(6); PG8_BAR;
    for (;;) {
        const bool has_next = S.next(ui + 1, nxt);
        const char* nA = has_next ? (const char*)g.A + (size_t)nxt.pm * tstep : cA; const char* nB = has_next ? (const char*)g.Bt + (size_t)nxt.pn * tstep : cB;
        for (int t = 0; t < nt; t += 2) {
            const bool last = (t == nt - 2);
            const char* a1 = cA + (size_t)(t + 1) * kstep;
            const char* a2 = last ? nA : cA + (size_t)(t + 2) * kstep; const char* b2 = last ? nB : cB + (size_t)(t + 2) * kstep;
            const char* a3 = a2 + kstep; const char* b3 = b2 + kstep;
            if (last && has_next) S.a_ready(nxt);
            PG8_LDB(B0, 0, 0); PG8_SCHED; PG8_LDA(At, 0, 0); PG8_STAGE(PG8_SA(1, 1), a1 + hstep, voffA);
            PG8_WAIT_L(8); PG8_BAR; PG8_WAIT_L(0); PG8_MMA(0, 0, At, B0); PG8_BAR; PG8_SCHED;
            PG8_LDB(B1, 0, 1); PG8_STAGE(PG8_SB(0, 0), b2, voffB);
            PG8_BAR; PG8_WAIT_L(0); PG8_MMA(0, 1, At, B1); PG8_BAR;
            PG8_LDA(At, 0, 1); PG8_STAGE(PG8_SA(0, 0), a2, voffA);
            PG8_BAR; PG8_WAIT_L(0); PG8_MMA(1, 0, At, B0); PG8_BAR; PG8_SCHED;
            PG8_STAGE(PG8_SB(0, 1), b2 + hstep, voffB);
            PG8_WAIT_V(6); PG8_BAR; PG8_MMA(1, 1, At, B1); PG8_BAR;
            PG8_LDB(B0, 1, 0); PG8_SCHED; PG8_LDA(At, 1, 0); PG8_STAGE(PG8_SA(0, 1), a2 + hstep, voffA);
            PG8_WAIT_L(8); PG8_BAR; PG8_WAIT_L(0); PG8_MMA(0, 0, At, B0); PG8_BAR; PG8_SCHED;
            PG8_LDB(B1, 1, 1); PG8_STAGE(PG8_SB(1, 0), b3, voffB);
            PG8_BAR; PG8_WAIT_L(0); PG8_MMA(0, 1, At, B1); PG8_BAR;
            PG8_LDA(At, 1, 1); PG8_STAGE(PG8_SA(1, 0), a3, voffA);
            PG8_BAR; PG8_WAIT_L(0); PG8_MMA(1, 0, At, B0); PG8_BAR; PG8_SCHED;
            PG8_STAGE(PG8_SB(1, 1), b3 + hstep, voffB);
            PG8_WAIT_V(6); PG8_BAR; PG8_MMA(1, 1, At, B1); PG8_BAR;
        }
        E(acc, cur, wr, wc, fr, fq); S.done(cur);
        if (!has_next) break;
#pragma unroll
        for (int a = 0; a < 2; ++a)
#pragma unroll
            for (int b = 0; b < 2; ++b)
#pragma unroll
                for (int m = 0; m < 4; ++m)
#pragma unroll
                    for (int n = 0; n < 2; ++n) acc[a][b][m][n] = (f32x4){0.f, 0.f, 0.f, 0.f};
        cur = nxt; cA = nA; cB = nB; ++ui;
    }
    PG8_WAIT_V(0);
    if (wr == 0) PG8_BAR;
    PG8_BAR;
#undef PG8_SA
#undef PG8_SB
#undef PG8_STAGE
#undef PG8_LDA
#undef PG8_LDB
#undef PG8_MMA
#undef PG8_WAIT_V
#undef PG8_WAIT_L
#undef PG8_BAR
#undef PG8_SCHED
}
}


struct Epi1 {
    static constexpr bool PERM = true;
    bf16_t* act;
    template <int MODE> __device__ __forceinline__ void pair(const f32x4 (&acc)[2][2][4][2], bf16_t* O, int row0, int col0) const {
#pragma unroll
        for (int ai = 0; ai < 2; ++ai)
#pragma unroll
            for (int m = 0; m < 4; ++m) {
                float r[8];
#pragma unroll
                for (int n = 0; n < 2; ++n)
#pragma unroll
                    for (int j = 0; j < 4; ++j) { const float a = acc[ai][0][m][n][j], b = acc[ai][1][m][n][j];
                        r[4 * n + j] = MODE == 0 ? a * b : (MODE == 1 ? a * silu(b) : a * sigm(b)); }
                *(u32x4*)(O + (size_t)(row0 + ai * 128 + m * 16) * D + col0) = pack8(r);
            }
    }
    template <int MODE> __device__ __forceinline__ void single(const f32x4 (&acc)[2][2][4][2], bf16_t* O, int row0, int col0) const {
#pragma unroll
        for (int bj = 0; bj < 2; ++bj)
#pragma unroll
            for (int ai = 0; ai < 2; ++ai)
#pragma unroll
                for (int m = 0; m < 4; ++m) {
                    float r[8];
#pragma unroll
                    for (int j = 0; j < 4; ++j) { const float v0 = acc[ai][bj][m][0][j], v1 = acc[ai][bj][m][1][j];
                        r[j] = MODE == 0 ? silu(v0) : v0; r[4 + j] = MODE == 0 ? silu(v1) : v1; }
                    *(u32x4*)(O + (size_t)(row0 + ai * 128 + m * 16) * D + col0 + bj * 128) = pack8(r);
                }
    }
    __device__ __forceinline__ void operator()(const f32x4 (&acc)[2][2][4][2], const pg8::Unit& u, int wr, int wc, int fr, int fq) const {
        const int row0 = u.pm * 256 + wr * 64 + fr, tile = u.pn;
        if (tile < 24) {
            const int grp = tile >> 3, col0 = 128 * (tile & 7) + wc * 32 + 8 * fq;
            if (grp == 0) pair<0>(acc, act + 1 * (SLOT / 2), row0, col0);
            else if (grp == 1) pair<1>(acc, act + 2 * (SLOT / 2), row0, col0);
            else pair<2>(acc, act + 4 * (SLOT / 2), row0, col0);
        } else {
            const int t2 = tile - 24, g2 = t2 >> 2, col0 = 256 * (t2 & 3) + wc * 32 + 8 * fq;
            if (g2 == 0) single<0>(acc, act + 3 * (SLOT / 2), row0, col0);
            else single<1>(acc, act + (4 + g2) * (SLOT / 2), row0, col0);
        }
    }
};

struct EpiY {
    static constexpr bool PERM = true;
    bf16_t* Y;
    __device__ __forceinline__ void operator()(const f32x4 (&acc)[2][2][4][2], const pg8::Unit& u, int wr, int wc, int fr, int fq) const {
        const int row0 = u.pm * 256 + wr * 64 + fr, col0 = (u.pn & 3) * 256 + wc * 32 + 8 * fq;
#pragma unroll
        for (int bj = 0; bj < 2; ++bj)
#pragma unroll
            for (int ai = 0; ai < 2; ++ai)
#pragma unroll
                for (int m = 0; m < 4; ++m) {
                    float r[8];
#pragma unroll
                    for (int j = 0; j < 4; ++j) { r[j] = acc[ai][bj][m][0][j]; r[4 + j] = acc[ai][bj][m][1][j]; }
                    *(u32x4*)(Y + (size_t)(row0 + ai * 128 + m * 16) * D + col0 + bj * 128) = pack8(r);
                }
    }
};
struct EpiF {
    static constexpr bool PERM = false;
    float* out;
    __device__ __forceinline__ void operator()(const f32x4 (&acc)[2][2][4][2], const pg8::Unit& u, int wr, int wc, int fr, int fq) const {
        const int row0 = u.pm * 256 + wr * 64 + fr, col0 = u.pn * 256 + wc * 32 + 4 * fq;
#pragma unroll
        for (int ai = 0; ai < 2; ++ai)
#pragma unroll
            for (int m = 0; m < 4; ++m) { float* rowp = out + (size_t)(row0 + ai * 128 + m * 16) * D + col0;
#pragma unroll
                for (int bj = 0; bj < 2; ++bj)
#pragma unroll
                    for (int n = 0; n < 2; ++n) *(f32x4*)(rowp + bj * 128 + n * 16) = acc[ai][bj][m][n]; }
    }
};

__device__ __forceinline__ int w1_srccol(int nc) {
    const int tile = nc >> 8, within = nc & 255;
    if (tile < 24) { const int grp = tile >> 3, half = within >> 7, ch = 128 * (tile & 7) + (within & 127);
        const int split = grp == 0 ? (half ? 2 : 1) : (grp == 1 ? (half ? 3 : 0) : (half ? 5 : 4));
        return split * 1024 + ch; }
    const int t2 = tile - 24;
    return (6 + (t2 >> 2)) * 1024 + 256 * (t2 & 3) + within;
}
__device__ __forceinline__ void transpose_item(const float* W, int ldw, int srccol0, bf16_t* WT, int row0, int k0, LAS float* scr, int lane) {
#pragma unroll 8
    for (int i = 0; i < 32; ++i) { const int kk = 2 * i + (lane >> 5); scr[kk * 33 + (lane & 31)] = W[(size_t)(k0 + kk) * ldw + srccol0 + (lane & 31)]; }
    asm volatile("s_waitcnt lgkmcnt(0)" ::: "memory");
    const int c = lane & 7;
#pragma unroll
    for (int j = 0; j < 4; ++j) { const int n = (lane >> 3) + 8 * j; const LAS float* s = scr + (8 * c) * 33 + n;
        u32x4 o; o.x = cvt_pk_bf16(s[0 * 33], s[1 * 33]); o.y = cvt_pk_bf16(s[2 * 33], s[3 * 33]); o.z = cvt_pk_bf16(s[4 * 33], s[5 * 33]); o.w = cvt_pk_bf16(s[6 * 33], s[7 * 33]);
        *(u32x4*)(WT + (size_t)(row0 + n) * D + k0 + 8 * c) = o; }
    asm volatile("s_waitcnt lgkmcnt(0)" ::: "memory");
}
__device__ __forceinline__ void p0_phase(LAS unsigned char* lds, const float* c, const float* w_ada, const float* b_ada, const float* w_in, const float* w_out_a, const float* w_out_b,
                                         const float* w_o, unsigned char* ws, int G) {
    const int tid = threadIdx.x, lane = tid & 63, wave = tid >> 6;
    float* mod = (float*)(ws + WS_MOD);
    for (int item = blockIdx.x; item < 192; item += G) {
        LAS float* cact = (LAS float*)lds;
        LAS float* red = (LAS float*)(lds + 32768);
        for (int i = tid; i < NBATCH * D; i += 512) cact[i] = silu(c[i]);
        __syncthreads();
        const int col = tid & 15, kg = tid >> 4, j = item * 16 + col;
        float a[8];
#pragma unroll
        for (int b = 0; b < 8; ++b) a[b] = 0.f;
#pragma unroll 8
        for (int kk = 0; kk < 32; ++kk) { const int k = kg * 32 + kk; const float w = w_ada[(size_t)k * (3 * D) + j];
#pragma unroll
            for (int b = 0; b < 8; ++b) a[b] = fmaf(cact[b * D + k], w, a[b]); }
#pragma unroll
        for (int b = 0; b < 8; ++b) red[(b * 16 + col) * 33 + kg] = a[b];
        __syncthreads();
        if (tid < 128) { const int b = tid >> 4, cl = tid & 15; float s = 0.f;
            for (int q = 0; q < 32; ++q) s += red[(b * 16 + cl) * 33 + q];
            mod[b * 3 * D + item * 16 + cl] = s + b_ada[item * 16 + cl]; }
        __syncthreads();
    }
    LAS float* scr = (LAS float*)(lds + wave * 8448);
    const int gw = blockIdx.x * 8 + wave, NGW = G * 8;
    bf16_t* W1T = (bf16_t*)(ws + WS_W1T); bf16_t* WAB = (bf16_t*)(ws + WS_WAB); bf16_t* WOT = (bf16_t*)(ws + WS_WOT);
    constexpr int I1 = 16 * (DIN / 32), I2 = 16 * (D / 32);
    for (int it = gw; it < I1 + 3 * I2; it += NGW) {
        int r = it;
        if (r < I1) { const int kb = r / (DIN / 32), nb = r % (DIN / 32); transpose_item(w_in, DIN, w1_srccol(nb * 32), W1T, nb * 32, kb * 64, scr, lane); continue; }
        r -= I1;
        const int which = r / I2; r -= which * I2;
        const int kb = r / (D / 32), nb = r % (D / 32);
        if (which == 0) transpose_item(w_out_a, D, nb * 32, WAB, nb * 32, kb * 64, scr, lane);
        else if (which == 1) transpose_item(w_out_b, D, nb * 32, WAB, D + nb * 32, kb * 64, scr, lane);
        else transpose_item(w_o, D, nb * 32, WOT, nb * 32, kb * 64, scr, lane);
    }
}

__device__ __forceinline__ void p1_phase(const float* x, const float* gain, const float* mod, bf16_t* H, int G) {
    const int lane = threadIdx.x & 63, gw = blockIdx.x * 8 + (threadIdx.x >> 6), NGW = G * 8;
    for (int row = gw; row < M; row += NGW) {
        const f32x4* xr = (const f32x4*)(x + (size_t)row * D) + lane;
        f32x4 v[4]; float ss = 0.f;
#pragma unroll
        for (int j = 0; j < 4; ++j) { v[j] = xr[64 * j]; ss += (v[j].x * v[j].x + v[j].y * v[j].y) + (v[j].z * v[j].z + v[j].w * v[j].w); }
        const float r = rsqrtf(wave_sum(ss) * (1.f / D) + EPS);
        const float* shift = mod + (size_t)(row >> 12) * 3 * D; const float* scale = shift + D;
#pragma unroll
        for (int j = 0; j < 4; ++j) { const int cidx = 4 * lane + 256 * j;
            const f32x4 g = *(const f32x4*)(gain + cidx), sc = *(const f32x4*)(scale + cidx), sh = *(const f32x4*)(shift + cidx);
            const f32x4 h = (v[j] * r) * g * (1.0f + sc) + sh;
            u32x2 o; o.x = cvt_pk_bf16(h.x, h.y); o.y = cvt_pk_bf16(h.z, h.w);
            *(u32x2*)(H + (size_t)row * D + cidx) = o; }
    }
}

__device__ __forceinline__ void p3a_phase(const bf16_t* CV, bf16_t* BZ, const float* wa, int G) {
    const int gt = blockIdx.x * 512 + threadIdx.x, NT = G * 512;
    for (int item = gt; item < (M / 4) * (D / 8); item += NT) {
        const int tq = item >> 7, cb = (item & 127) * 8, t0 = tq * 4, p0 = t0 & (SEQ - 1);
        float w0[8], w1[8], w2[8];
        { const f32x4 a = *(const f32x4*)(wa + cb), b = *(const f32x4*)(wa + cb + 4), c2 = *(const f32x4*)(wa + D + cb), d = *(const f32x4*)(wa + D + cb + 4),
              e2 = *(const f32x4*)(wa + 2 * D + cb), f = *(const f32x4*)(wa + 2 * D + cb + 4);
#pragma unroll
          for (int e = 0; e < 4; ++e) { w0[e] = a[e]; w0[4 + e] = b[e]; w1[e] = c2[e]; w1[4 + e] = d[e]; w2[e] = e2[e]; w2[4 + e] = f[e]; } }
        u32x4 rows[6], bzr[4];
#pragma unroll
        for (int i = 0; i < 6; ++i) { const int pos = p0 - 1 + i; rows[i] = (u32x4){0u, 0u, 0u, 0u};
            if (pos >= 0 && pos < SEQ) rows[i] = *(const u32x4*)(CV + (size_t)(t0 - 1 + i) * D + cb); }
#pragma unroll
        for (int j = 0; j < 4; ++j) bzr[j] = *(const u32x4*)(BZ + (size_t)(t0 + j) * D + cb);
#pragma unroll
        for (int j = 0; j < 4; ++j) { float a[8], b[8], c[8], bz[8], r[8];
            unpack8(rows[j], a); unpack8(rows[j + 1], b); unpack8(rows[j + 2], c); unpack8(bzr[j], bz);
#pragma unroll
            for (int e = 0; e < 8; ++e) r[e] = bz[e] * (w0[e] * a[e] + w1[e] * b[e] + w2[e] * c[e]);
            *(u32x4*)(BZ + (size_t)(t0 + j) * D + cb) = pack8(r); }
    }
}
__device__ __forceinline__ void p3b_phase(LAS unsigned char* lds, bf16_t* SZ, const bf16_t* U, const float* wb, const float* cbias, const float* lng, const float* lnb, int G) {
    const int tid = threadIdx.x, co = tid & 31, tg = tid >> 5;
    LAS unsigned char* ut = lds;
    LAS unsigned char* wt = lds + 49152;
    for (int tile = blockIdx.x; tile < M / 64; tile += G) {
        const int t0 = tile * 64, p0 = t0 & (SEQ - 1);
        u32x4 pk[4][4];
        float s1[4], s2[4];
#pragma unroll
        for (int j = 0; j < 4; ++j) { s1[j] = 0.f; s2[j] = 0.f; }
#pragma unroll
        for (int ch = 0; ch < 4; ++ch) {
            __syncthreads();
            int c0 = ch * 256; asm volatile("" : "+s"(c0) :: "memory");
            const int cb = c0 + co * 8;
            {   const bf16_t* ug = U + (size_t)(t0 - 15 + tg) * D + c0 + co * 8; LAS unsigned char* ul = ut + tg * 512 + co * 16;
#pragma unroll
                for (int it = 0; it < 6; ++it) { const int r = it * 16 + tg, pos = p0 - 15 + r;
                    if (it < 5 || tg < 14) { u32x4 v = (u32x4){0u, 0u, 0u, 0u};
                        if (pos >= 0 && pos < SEQ) v = *(const u32x4*)(ug + (size_t)it * 16 * D);
                        *(LAS u32x4*)(ul + it * 8192) = v; } }
                const int wv = tid >> 6, cc = tid & 63;
                const float* wg = wb + (size_t)wv * D + c0 + cc * 4; LAS unsigned char* wl = wt + ((wv * 2 + (cc & 1)) * 32 + (cc >> 1)) * 16;
#pragma unroll
                for (int it = 0; it < 4; ++it) { if (it < 3 || wv < 7) *(LAS f32x4*)(wl + it * 8192) = *(const f32x4*)(wg + (size_t)it * 8 * D); } }
            __syncthreads();
            float acc[4][8];
            {   const f32x4 b0 = *(const f32x4*)(cbias + cb), b1 = *(const f32x4*)(cbias + cb + 4);
#pragma unroll
                for (int j = 0; j < 4; ++j)
#pragma unroll
                    for (int e = 0; e < 4; ++e) { acc[j][e] = b0[e]; acc[j][4 + e] = b1[e]; } }
            const LAS unsigned char* ub = ut + (tg * 4) * 512 + co * 16;
            const LAS unsigned char* wp = wt + co * 16;
#pragma unroll 1
            for (int k = 0; k < 30; k += 2) {
                float ur[5][8];
#pragma unroll
                for (int i = 0; i < 5; ++i) unpack8(*(const LAS u32x4*)(ub + (k + i) * 512), ur[i]);
                const f32x4 wa0 = *(const LAS f32x4*)(wp + k * 1024), wa1 = *(const LAS f32x4*)(wp + k * 1024 + 512);
                const f32x4 wb0 = *(const LAS f32x4*)(wp + k * 1024 + 1024), wb1 = *(const LAS f32x4*)(wp + k * 1024 + 1536);
#pragma unroll
                for (int j = 0; j < 4; ++j)
#pragma unroll
                    for (int e = 0; e < 4; ++e) {
                        acc[j][e] = fmaf(wb0[e], ur[j + 1][e], fmaf(wa0[e], ur[j][e], acc[j][e]));
                        acc[j][4 + e] = fmaf(wb1[e], ur[j + 1][4 + e], fmaf(wa1[e], ur[j][4 + e], acc[j][4 + e])); }
            }
            {   float ur[4][8];
#pragma unroll
                for (int i = 0; i < 4; ++i) unpack8(*(const LAS u32x4*)(ub + (30 + i) * 512), ur[i]);
                const f32x4 wa0 = *(const LAS f32x4*)(wp + 30 * 1024), wa1 = *(const LAS f32x4*)(wp + 30 * 1024 + 512);
#pragma unroll
                for (int j = 0; j < 4; ++j)
#pragma unroll
                    for (int e = 0; e < 4; ++e) { acc[j][e] = fmaf(wa0[e], ur[j][e], acc[j][e]); acc[j][4 + e] = fmaf(wa1[e], ur[j][4 + e], acc[j][4 + e]); }
            }
#pragma unroll
            for (int j = 0; j < 4; ++j) {
#pragma unroll
                for (int e = 0; e < 8; ++e) { s1[j] += acc[j][e]; s2[j] = fmaf(acc[j][e], acc[j][e], s2[j]); }
                pk[ch][j] = pack8(acc[j]); }
        }
        float mean[4], rstd[4];
#pragma unroll
        for (int j = 0; j < 4; ++j) { mean[j] = half_sum(s1[j]) * (1.f / D); const float ex2 = half_sum(s2[j]) * (1.f / D);
            rstd[j] = rsqrtf(fmaxf(ex2 - mean[j] * mean[j], 0.f) + EPS); }
#pragma unroll
        for (int ch = 0; ch < 4; ++ch) { int c0 = ch * 256; asm volatile("" : "+s"(c0) :: "memory"); const int cb = c0 + co * 8;
            float g[8], b[8];
            { const f32x4 g0 = *(const f32x4*)(lng + cb), g1 = *(const f32x4*)(lng + cb + 4), b0 = *(const f32x4*)(lnb + cb), b1 = *(const f32x4*)(lnb + cb + 4);
#pragma unroll
              for (int e = 0; e < 4; ++e) { g[e] = g0[e]; g[4 + e] = g1[e]; b[e] = b0[e]; b[4 + e] = b1[e]; } }
#pragma unroll
            for (int j = 0; j < 4; ++j) { const size_t off = (size_t)(t0 + tg * 4 + j) * D + cb;
                float sz[8], v[8], r[8]; unpack8(*(const u32x4*)(SZ + off), sz); unpack8(pk[ch][j], v);
#pragma unroll
                for (int e = 0; e < 8; ++e) { const float y = (v[e] - mean[j]) * rstd[j] * g[e] + b[e]; r[e] = silu(y) * sz[e]; }
                *(u32x4*)(SZ + off) = pack8(r); } }
    }
}

__device__ __forceinline__ void merge_phase(const bf16_t* MA, const bf16_t* MB, const bf16_t* YA, const bf16_t* YB, bf16_t* MG, const float* bmerge, const float* bob, int G) {
    const int gt = blockIdx.x * 512 + threadIdx.x, NT = G * 512;
    const int cb = (gt & 127) * 8;
    float ba[8], bb[8], bo[8];
    { const f32x4 a0 = *(const f32x4*)(bmerge + cb), a1 = *(const f32x4*)(bmerge + cb + 4), b0 = *(const f32x4*)(bmerge + D + cb), b1 = *(const f32x4*)(bmerge + D + cb + 4),
          c0 = *(const f32x4*)(bob + cb), c1 = *(const f32x4*)(bob + cb + 4);
#pragma unroll
      for (int e = 0; e < 4; ++e) { ba[e] = a0[e]; ba[4 + e] = a1[e]; bb[e] = b0[e]; bb[4 + e] = b1[e]; bo[e] = c0[e]; bo[4 + e] = c1[e]; } }
    for (size_t i = gt; i < (size_t)M * D / 8; i += NT) {
        float ma[8], mb[8], ya[8], yb[8], r[8];
        unpack8(*(const u32x4*)(MA + i * 8), ma); unpack8(*(const u32x4*)(MB + i * 8), mb); unpack8(*(const u32x4*)(YA + i * 8), ya); unpack8(*(const u32x4*)(YB + i * 8), yb);
#pragma unroll
        for (int e = 0; e < 8; ++e) r[e] = sigm(ma[e] + ba[e]) * ya[e] + sigm(mb[e] + bb[e]) * (yb[e] + bo[e]);
        *(u32x4*)(MG + i * 8) = pack8(r);
    }
}

__device__ __forceinline__ void p7_phase(float* out, const float* x, const float* mod, const float* fgain, int G) {
    const int lane = threadIdx.x & 63, gw = blockIdx.x * 8 + (threadIdx.x >> 6), NGW = G * 8;
    f32x4 g[4];
#pragma unroll
    for (int j = 0; j < 4; ++j) g[j] = *(const f32x4*)(fgain + 4 * lane + 256 * j);
    for (int row = gw; row < M; row += NGW) {
        f32x4* yr = (f32x4*)(out + (size_t)row * D) + lane; const f32x4* xr = (const f32x4*)(x + (size_t)row * D) + lane;
        const f32x4* gt = (const f32x4*)(mod + (size_t)(row >> 12) * 3 * D + 2 * D) + lane;
        f32x4 v[4]; float ss = 0.f;
#pragma unroll
        for (int j = 0; j < 4; ++j) { v[j] = xr[64 * j] + gt[64 * j] * yr[64 * j]; ss += (v[j].x * v[j].x + v[j].y * v[j].y) + (v[j].z * v[j].z + v[j].w * v[j].w); }
        const float r = rsqrtf(wave_sum(ss) * (1.f / D) + EPS);
#pragma unroll
        for (int j = 0; j < 4; ++j) yr[64 * j] = (v[j] * r) * g[j];
    }
}


#define XB_TMO      128
#define XB_XCNT(j)  (256  + 64 * (j))
#define XB_XSUB(j)  (1280 + 64 * (j))
#define XB_XGEN(j)  (2304 + 64 * (j))
#define XB_TOP      3328
#define XB_TOPGEN   3392
#define XCD_BAR_WORDS 3456
#define XB_SPIN_CAP (1u << 18)
__device__ __forceinline__ unsigned xb_ld(unsigned* p)              { return __hip_atomic_load(p, __ATOMIC_RELAXED, __HIP_MEMORY_SCOPE_AGENT); }
__device__ __forceinline__ unsigned xb_add(unsigned* p, unsigned v) { return __hip_atomic_fetch_add(p, v, __ATOMIC_RELAXED, __HIP_MEMORY_SCOPE_AGENT); }
__device__ __forceinline__ unsigned xb_xcc_id() { return (unsigned)__builtin_amdgcn_s_getreg((3 << 11) | 20) & 0xFu; }
#define XB_SPIN(cond, bar) do { unsigned _sp = 0; while (cond) { __builtin_amdgcn_s_sleep(1); \
    if ((++_sp & 255u) == 0u) { if (xb_ld(&(bar)[XB_TMO])) break; if (_sp > XB_SPIN_CAP) { atomicAdd(&(bar)[XB_TMO], 1u); break; } } } } while (0)
struct XcdBarrier { unsigned* bar; unsigned x; volatile LAS unsigned* st; };
__device__ __forceinline__ XcdBarrier xcd_barrier_post(unsigned* bar, volatile LAS unsigned* st) {
    XcdBarrier b; b.bar = bar; b.x = xb_xcc_id(); b.st = st;
    if (threadIdx.x == 0) (void)xb_add(&bar[XB_XCNT(b.x)], 1u);
    return b;
}
__device__ __forceinline__ void xcd_barrier_complete(unsigned* bar, unsigned x, unsigned& nloc, unsigned& nx) {
    const unsigned G = gridDim.x * gridDim.y * gridDim.z;
    unsigned sum, cnt, mine, sp = 0u;
    for (;;) {
        sum = 0u; cnt = 0u; mine = 0u;
#pragma unroll
        for (unsigned j = 0; j < 16; ++j) { const unsigned c = xb_ld(&bar[XB_XCNT(j)]); sum += c; cnt += (c > 0u) ? 1u : 0u; mine = (j == x) ? c : mine; }
        if (sum == G) break;
        __builtin_amdgcn_s_sleep(1);
        if ((++sp & 255u) == 0u) { if (xb_ld(&bar[XB_TMO])) break; if (sp > XB_SPIN_CAP) { atomicAdd(&bar[XB_TMO], 1u); break; } }
    }
    nloc = mine > 0u ? mine : 1u; nx = cnt > 0u ? cnt : 1u;
}
__device__ __forceinline__ void xcd_barrier(const XcdBarrier& b) {
    asm volatile("s_waitcnt vmcnt(0)" ::: "memory");
    __syncthreads();
    if (threadIdx.x == 0) {
        unsigned* bar = b.bar;
        __builtin_amdgcn_s_waitcnt(0);
        unsigned nloc = b.st[0], nx = b.st[1];
        if (nloc == 0u) { xcd_barrier_complete(bar, b.x, nloc, nx); b.st[0] = nloc; b.st[1] = nx; }
        const unsigned old = xb_add(&bar[XB_XSUB(b.x)], 1u);
        const unsigned gen = old / nloc;
        if (old + 1u == (gen + 1u) * nloc) {
            __builtin_amdgcn_fence(__ATOMIC_RELEASE, "agent");
            asm volatile("s_waitcnt vmcnt(0)" ::: "memory");
            const unsigned og = xb_add(&bar[XB_TOP], 1u);
            const unsigned tg = og / nx;
            if (og + 1u == (tg + 1u) * nx) xb_add(&bar[XB_TOPGEN], 1u);
            else XB_SPIN(xb_ld(&bar[XB_TOPGEN]) == tg, bar);
            __builtin_amdgcn_fence(__ATOMIC_ACQUIRE, "agent");
            xb_add(&bar[XB_XGEN(b.x)], 1u);
            asm volatile("s_waitcnt vmcnt(0)" ::: "memory");
        } else {
            XB_SPIN(xb_ld(&bar[XB_XGEN(b.x)]) == gen, bar);
            __builtin_amdgcn_fence(__ATOMIC_ACQUIRE, "agent");
            asm volatile("s_waitcnt vmcnt(0)" ::: "memory");
        }
    }
    __syncthreads();
}

struct Args { const float* in[17]; float* out; unsigned char* ws; int ph_lo, ph_hi; };

__global__ void __launch_bounds__(512, 2) fwd_kernel(Args a) {
    extern __shared__ __attribute__((aligned(16))) unsigned char shm[];
    LAS unsigned char* lds = (LAS unsigned char*)shm;
    cg::grid_group grid = cg::this_grid();
    const int G = gridDim.x, lo = a.ph_lo, hi = a.ph_hi;
    unsigned char* ws = a.ws;
    bf16_t* act = (bf16_t*)(ws + WS_ACT);
    const float* mod = (const float*)(ws + WS_MOD);
#define IN(k) (lo <= (k) && (k) < hi)
#define SEAM(k) do { if (IN(k) && IN((k) + 1)) { if ((k) == 0) grid.sync(); else xcd_barrier(xbar); } } while (0)
    volatile LAS unsigned* xst = (volatile LAS unsigned*)(lds + 131072);
    if (threadIdx.x < 4) xst[threadIdx.x] = 0u;
    __syncthreads();
    XcdBarrier xbar; xbar.bar = (unsigned*)(ws + WS_BAR); xbar.x = 0; xbar.st = xst;
    if (hi - lo > 1) xbar = xcd_barrier_post((unsigned*)(ws + WS_BAR), xst);
    if (IN(0)) p0_phase(lds, a.in[1], a.in[3], a.in[4], a.in[5], a.in[8], a.in[13], a.in[15], ws, G);
    SEAM(0);
    if (IN(1)) p1_phase(a.in[0], a.in[2], mod, act, G);
    SEAM(1);
    if (IN(2)) { pg8::Gemm g{act, (const bf16_t*)(ws + WS_W1T), M, DIN, D}; pg8::StaticOrder S; S.init(M, DIN, G, (int)blockIdx.x);
        Epi1 E{act}; pg8::gemm_phase<Epi1, pg8::StaticOrder>(lds, g, S, E); }
    SEAM(2);
    if (IN(3)) { p3a_phase(act + 1 * (SLOT / 2), act + 2 * (SLOT / 2), a.in[7], G);
        p3b_phase(lds, act + 3 * (SLOT / 2), act + 4 * (SLOT / 2), a.in[9], a.in[10], a.in[11], a.in[12], G); }
    SEAM(3);
    if (IN(4)) { pg8::Gemm g{act + 2 * (SLOT / 2), (const bf16_t*)(ws + WS_WAB), M, D, D}; pg8::PairOrder S; S.init(M, D, G, (int)blockIdx.x);
        EpiY E{act}; pg8::gemm_phase<EpiY, pg8::PairOrder>(lds, g, S, E); }
    SEAM(4);
    if (IN(5)) merge_phase(act + 5 * (SLOT / 2), act + 6 * (SLOT / 2), act, act + 1 * (SLOT / 2), act + 4 * (SLOT / 2), a.in[6], a.in[14], G);
    SEAM(5);
    if (IN(6)) { pg8::Gemm g{act + 4 * (SLOT / 2), (const bf16_t*)(ws + WS_WOT), M, D, D}; pg8::StaticOrder S; S.init(M, D, G, (int)blockIdx.x);
        EpiF E{a.out}; pg8::gemm_phase<EpiF, pg8::StaticOrder>(lds, g, S, E); }
    SEAM(6);
    if (IN(7)) p7_phase(a.out, a.in[0], mod, a.in[16], G);
#undef IN
#undef SEAM
}

extern "C" void kernel_launch(void* const* d_in, const int* in_sizes, int n_in, void* d_out, int out_size, void* d_ws, size_t ws_size, hipStream_t stream) {
    static int grid = 0;
    if (grid == 0) {
        if (n_in != 17 || out_size != M * D || ws_size < WS_END) { fprintf(stderr, "kernel_launch: unexpected shapes (n_in %d out %d ws %zu, need %zu)\n", n_in, out_size, ws_size, (size_t)WS_END); grid = -1; return; }
        int dev = 0, cus = 0, per_cu = 0;
        (void)hipGetDevice(&dev); (void)hipDeviceGetAttribute(&cus, hipDeviceAttributeMultiprocessorCount, dev);
        if (hipFuncSetAttribute((const void*)fwd_kernel, hipFuncAttributeMaxDynamicSharedMemorySize, LDS_BYTES) != hipSuccess) { fprintf(stderr, "kernel_launch: hipFuncSetAttribute failed\n"); grid = -1; return; }
        if (hipOccupancyMaxActiveBlocksPerMultiprocessor(&per_cu, (const void*)fwd_kernel, 512, LDS_BYTES) != hipSuccess || per_cu < 1) { fprintf(stderr, "kernel_launch: occupancy query says %d\n", per_cu); per_cu = 1; }
        (void)hipGetLastError();
        grid = cus;
    }
    if (grid < 0) return;
    Args a{};
    for (int i = 0; i < 17; ++i) a.in[i] = (const float*)d_in[i];
    a.out = (float*)d_out; a.ws = (unsigned char*)d_ws;
#if N_LAUNCHES == 1
    (void)hipMemsetAsync((char*)d_ws + WS_BAR, 0, XCD_BAR_WORDS * 4, stream);
    a.ph_lo = 0; a.ph_hi = 8;
    void* args[] = {&a};
    hipError_t e = hipLaunchCooperativeKernel((const void*)fwd_kernel, dim3(grid), dim3(512), args, LDS_BYTES, stream);
    if (e != hipSuccess) fprintf(stderr, "cooperative launch failed: %s (grid %d)\n", hipGetErrorString(e), grid);
#else
    for (int ph = 0; ph < 8; ++ph) { a.ph_lo = ph; a.ph_hi = ph + 1; hipLaunchKernelGGL(fwd_kernel, dim3(grid), dim3(512), LDS_BYTES, stream, a); }
#endif
}
```

```cpp
#include <hip/hip_runtime.h>
#include <hip/hip_cooperative_groups.h>
#include <cstdio>
namespace cg = cooperative_groups;

#ifndef N_LAUNCHES
#define N_LAUNCHES 1
#endif

#define LAS __attribute__((address_space(3)))
typedef unsigned short bf16_t;
typedef short bf16x8 __attribute__((ext_vector_type(8)));
typedef float f32x4 __attribute__((ext_vector_type(4)));
typedef unsigned u32x4 __attribute__((ext_vector_type(4)));
typedef unsigned u32x2 __attribute__((ext_vector_type(2)));

constexpr int D = 1024, NBATCH = 8, SEQ = 4096, M = NBATCH * SEQ, DIN = 9216;
constexpr float EPS = 1e-6f;
constexpr int LDS_BYTES = 131072 + 16;

constexpr size_t WS_W1T = 0;
constexpr size_t WS_WAB = WS_W1T + (size_t)DIN * D * 2;
constexpr size_t WS_WOT = WS_WAB + (size_t)2 * D * D * 2;
constexpr size_t WS_MOD = WS_WOT + (size_t)D * D * 2;
constexpr size_t WS_BAR = WS_MOD + 98304;
constexpr size_t WS_ACT = WS_MOD + 131072;
constexpr size_t SLOT = (size_t)M * D * 2;
constexpr size_t WS_END = WS_ACT + 7 * SLOT;

__device__ __forceinline__ float bflo(unsigned u) { return __uint_as_float(u << 16); }
__device__ __forceinline__ float bfhi(unsigned u) { return __uint_as_float(u & 0xffff0000u); }
__device__ __forceinline__ unsigned cvt_pk_bf16(float lo, float hi) { unsigned r; asm("v_cvt_pk_bf16_f32 %0, %1, %2" : "=v"(r) : "v"(lo), "v"(hi)); return r; }
__device__ __forceinline__ float sigm(float x) { return __builtin_amdgcn_rcpf(1.0f + __builtin_amdgcn_exp2f(-1.44269504f * x)); }
__device__ __forceinline__ float silu(float x) { return x * sigm(x); }
__device__ __forceinline__ void unpack8(const u32x4 v, float (&f)[8]) {
    f[0] = bflo(v.x); f[1] = bfhi(v.x); f[2] = bflo(v.y); f[3] = bfhi(v.y); f[4] = bflo(v.z); f[5] = bfhi(v.z); f[6] = bflo(v.w); f[7] = bfhi(v.w);
}
__device__ __forceinline__ u32x4 pack8(const float (&f)[8]) {
    u32x4 o; o.x = cvt_pk_bf16(f[0], f[1]); o.y = cvt_pk_bf16(f[2], f[3]); o.z = cvt_pk_bf16(f[4], f[5]); o.w = cvt_pk_bf16(f[6], f[7]); return o;
}
__device__ __forceinline__ float wave_sum(float v) {
#pragma unroll
    for (int o = 1; o < 64; o <<= 1) v += __shfl_xor(v, o);
    return v;
}
__device__ __forceinline__ float half_sum(float v) {
#pragma unroll
    for (int o = 1; o < 32; o <<= 1) v += __shfl_xor(v, o);
    return v;
}

namespace pg8 {
constexpr int BM = 256, BK = 64, HALF = 128, HTB = HALF * BK * 2, STAGE_BYTES = 8 * HTB, NXCD = 8, WGM = 8;
__host__ __device__ __forceinline__ int lds_byte(int r, int c) { const int st = (r >> 4) * 2 + (c >> 5), rr = r & 15, cc = c & 31, ob = rr * 64 + cc * 2; return st * 1024 + (ob ^ (((ob >> 9) & 1) << 5)); }
__host__ __device__ __forceinline__ void stage_rc(int b, int& R, int& C) { const int st = b / 1024, sb = b % 1024, swz = sb ^ (((sb >> 9) & 1) << 5); R = (st >> 1) * 16 + swz / 64; C = (st & 1) * 32 + (swz % 64) / 2; }
__host__ __device__ __forceinline__ int perm32(int rho) { const int n = rho >> 4, i = rho & 15; return 8 * (i >> 2) + 4 * n + (i & 3); }

struct Unit { int pm, pn; };
struct Gemm { const bf16_t* A; const bf16_t* Bt; int M, N, K; };

struct StaticOrder {
    int nM, nN, nwg, G, c;
    __device__ void init(int M_, int N_, int G_, int c_) { nM = M_ / BM; nN = N_ / BM; nwg = nM * nN; G = G_; c = c_; }
    __device__ bool map(long L, Unit& u) const {
        if (L >= nwg) return false;
        int wgid = (int)L; { const int q = nwg / NXCD, r = nwg % NXCD, xcd = wgid % NXCD, off = wgid / NXCD; wgid = (xcd < r ? xcd * (q + 1) : r * (q + 1) + (xcd - r) * q) + off; }
        const int nig = WGM * nN, gid = wgid / nig, fm = gid * WGM, gsz = (nM - fm) < WGM ? (nM - fm) : WGM;
        u.pm = fm + ((wgid % nig) % gsz); u.pn = (wgid % nig) / gsz; return true;
    }
    __device__ bool next(int i, Unit& u) const { return map((long)i * G + c, u); }
    __device__ __forceinline__ void a_ready(const Unit&) const {}
    __device__ __forceinline__ void done(const Unit&) const {}
};
struct PairOrder : StaticOrder {
    __device__ bool next(int i, Unit& u) const {
        const int j = i >> 1, h = i & 1;
        if (!map((long)j * G + c, u)) return false;
        u.pm += h * nM; u.pn += h * nN; return true;
    }
};

template <class Epi, class Sched, bool ALIGN_EPI = false, bool SP2 = false>
__device__ __forceinline__ void gemm_phase(LAS unsigned char* lds, const Gemm g, const Sched& S, const Epi& E) {
    const int tid = threadIdx.x, wid = __builtin_amdgcn_readfirstlane(tid >> 6), lane = tid & 63, wr = wid >> 2, wc = wid & 3, fr = lane & 15, fq = lane >> 4;
    const int K = g.K, nt = K / BK;
    unsigned voffA[2], voffB[2];
#pragma unroll
    for (int i = 0; i < 2; ++i) { int R, C; stage_rc(tid * 16 + i * 8192, R, C); const int Rb = Epi::PERM ? ((R & ~31) + perm32(R & 31)) : R;
        voffA[i] = (unsigned)(R * K + C) * 2u; voffB[i] = (unsigned)(Rb * K + C) * 2u; }
    const size_t kstep = (size_t)(BK * 2);
    const size_t hstep = (size_t)HALF * K * 2;
    const size_t tstep = 2 * hstep;
    const unsigned ldsw = (unsigned)wid * 1024u;
    const int aoff = lds_byte(wr * 64 + fr, fq * 8), boff = lds_byte(wc * 32 + fr, fq * 8);
#define PG8_SA(b, h) (((b) * 2 + (h)) * HTB)
#define PG8_SB(b, h) ((4 + (b) * 2 + (h)) * HTB)
#define PG8_STAGE(bufoff, gbase, voff) do { _Pragma("unroll") for (int _i = 0; _i < 2; ++_i) \
        __builtin_amdgcn_global_load_lds((const unsigned*)((const char*)(gbase) + (voff)[_i]), (LAS unsigned*)(lds + (bufoff) + ldsw + _i * 8192), 16, 0, 0); } while (0)
#define PG8_LDA(dst, b, h) do { _Pragma("unroll") for (int m = 0; m < 4; ++m) _Pragma("unroll") for (int k = 0; k < 2; ++k) dst[m][k] = *(const LAS bf16x8*)(lds + PG8_SA(b, h) + aoff + m * 2048 + k * 1024); } while (0)
#define PG8_LDB(dst, b, h) do { _Pragma("unroll") for (int n = 0; n < 2; ++n) _Pragma("unroll") for (int k = 0; k < 2; ++k) dst[n][k] = *(const LAS bf16x8*)(lds + PG8_SB(b, h) + boff + n * 2048 + k * 1024); } while (0)
#define PG8_MMA(ai, bj, At, Bt) do { __builtin_amdgcn_s_setprio(1); _Pragma("unroll") for (int m = 0; m < 4; ++m) _Pragma("unroll") for (int n = 0; n < 2; ++n) _Pragma("unroll") for (int k = 0; k < 2; ++k) \
        acc[ai][bj][m][n] = __builtin_amdgcn_mfma_f32_16x16x32_bf16(Bt[n][k], At[m][k], acc[ai][bj][m][n], 0, 0, 0); __builtin_amdgcn_s_setprio(0); } while (0)
#define PG8_WAIT_V(n) asm volatile("s_waitcnt vmcnt(" #n ")" ::: "memory")
#define PG8_WAIT_L(n) asm volatile("s_waitcnt lgkmcnt(" #n ")" ::: "memory")
#define PG8_BAR __builtin_amdgcn_s_barrier()
#define PG8_SCHED __builtin_amdgcn_sched_barrier(0)
    Unit cur, nxt; int ui = 0;
    if (!S.next(0, cur)) return;
    f32x4 acc[2][2][4][2];
#pragma unroll
    for (int a = 0; a < 2; ++a)
#pragma unroll
        for (int b = 0; b < 2; ++b)
#pragma unroll
            for (int m = 0; m < 4; ++m)
#pragma unroll
                for (int n = 0; n < 2; ++n) acc[a][b][m][n] = (f32x4){0.f, 0.f, 0.f, 0.f};
    bf16x8 At[4][2], B0[2][2], B1[2][2];
    const char* cA = (const char*)g.A + (size_t)cur.pm * tstep; const char* cB = (const char*)g.Bt + (size_t)cur.pn * tstep;
    S.a_ready(cur);
    if constexpr (SP2) {
        PG8_STAGE(PG8_SB(0, 0), cB, voffB); PG8_STAGE(PG8_SB(0, 1), cB + hstep, voffB); PG8_STAGE(PG8_SA(0, 0), cA, voffA); PG8_STAGE(PG8_SA(0, 1), cA + hstep, voffA);
        if (wr == 1) PG8_BAR;
        PG8_WAIT_V(2); PG8_BAR;
        PG8_STAGE(PG8_SB(1, 0), cB + kstep, voffB); PG8_STAGE(PG8_SA(1, 0), cA + kstep, voffA); PG8_STAGE(PG8_SB(1, 1), cB + hstep + kstep, voffB);
        PG8_WAIT_V(6); PG8_BAR;
    } else {
        PG8_STAGE(PG8_SB(0, 0), cB, voffB); PG8_STAGE(PG8_SA(0, 0), cA, voffA); PG8_STAGE(PG8_SB(0, 1), cB + hstep, voffB); PG8_STAGE(PG8_SA(0, 1), cA + hstep, voffA);
        if (wr == 1) PG8_BAR;
        PG8_WAIT_V(4); PG8_BAR;
        PG8_STAGE(PG8_SB(1, 0), cB + kstep, voffB); PG8_STAGE(PG8_SA(1, 0), cA + kstep, voffA); PG8_STAGE(PG8_SB(1, 1), cB + hstep + kstep, voffB);
        PG8_WAIT_V(6); PG8_BAR;
    }
    for (;;) {
        const bool has_next = S.next(ui + 1, nxt);
        const char* nA = has_next ? (const char*)g.A + (size_t)nxt.pm * tstep : cA; const char* nB = has_next ? (const char*)g.Bt + (size_t)nxt.pn * tstep : cB;
        for (int t = 0; t < nt; t += 2) {
            const bool last = (t == nt - 2);
            const char* a1 = cA + (size_t)(t + 1) * kstep;
            const char* a2 = last ? nA : cA + (size_t)(t + 2) * kstep; const char* b2 = last ? nB : cB + (size_t)(t + 2) * kstep;
            const char* a3 = a2 + kstep; const char* b3 = b2 + kstep;
            if (last && has_next) S.a_ready(nxt);
            if constexpr (SP2) {
            PG8_LDB(B0, 0, 0); PG8_LDB(B1, 0, 1); PG8_SCHED; PG8_LDA(At, 0, 0); PG8_STAGE(PG8_SA(1, 1), a1 + hstep, voffA);
            PG8_WAIT_V(8); PG8_WAIT_L(0); PG8_BAR; PG8_MMA(0, 0, At, B0); PG8_MMA(0, 1, At, B1); PG8_BAR; PG8_SCHED;
            PG8_LDA(At, 0, 1); PG8_STAGE(PG8_SB(0, 0), b2, voffB); PG8_STAGE(PG8_SB(0, 1), b2 + hstep, voffB); PG8_STAGE(PG8_SA(0, 0), a2, voffA);
            PG8_WAIT_V(8); PG8_WAIT_L(0); PG8_BAR; PG8_MMA(1, 0, At, B0); PG8_MMA(1, 1, At, B1); PG8_BAR; PG8_SCHED;
            PG8_LDB(B0, 1, 0); PG8_LDB(B1, 1, 1); PG8_SCHED; PG8_LDA(At, 1, 0); PG8_STAGE(PG8_SA(0, 1), a2 + hstep, voffA);
            PG8_WAIT_V(8); PG8_WAIT_L(0); PG8_BAR; PG8_MMA(0, 0, At, B0); PG8_MMA(0, 1, At, B1); PG8_BAR; PG8_SCHED;
            PG8_LDA(At, 1, 1); PG8_STAGE(PG8_SB(1, 0), b3, voffB); PG8_STAGE(PG8_SB(1, 1), b3 + hstep, voffB); PG8_STAGE(PG8_SA(1, 0), a3, voffA);
            PG8_WAIT_V(8); PG8_WAIT_L(0); PG8_BAR; PG8_MMA(1, 0, At, B0); PG8_MMA(1, 1, At, B1); PG8_BAR; PG8_SCHED;
            } else {
            PG8_LDB(B0, 0, 0); PG8_SCHED; PG8_LDA(At, 0, 0); PG8_STAGE(PG8_SA(1, 1), a1 + hstep, voffA);
            PG8_WAIT_L(8); PG8_BAR; PG8_WAIT_L(0); PG8_MMA(0, 0, At, B0); PG8_BAR; PG8_SCHED;
            PG8_LDB(B1, 0, 1); PG8_STAGE(PG8_SB(0, 0), b2, voffB);
            PG8_BAR; PG8_WAIT_L(0); PG8_MMA(0, 1, At, B1); PG8_BAR;
            PG8_LDA(At, 0, 1); PG8_STAGE(PG8_SA(0, 0), a2, voffA);
            PG8_BAR; PG8_WAIT_L(0); PG8_MMA(1, 0, At, B0); PG8_BAR; PG8_SCHED;
            PG8_STAGE(PG8_SB(0, 1), b2 + hstep, voffB);
            PG8_WAIT_V(6); PG8_BAR; PG8_MMA(1, 1, At, B1); PG8_BAR;
            PG8_LDB(B0, 1, 0); PG8_SCHED; PG8_LDA(At, 1, 0); PG8_STAGE(PG8_SA(0, 1), a2 + hstep, voffA);
            PG8_WAIT_L(8); PG8_BAR; PG8_WAIT_L(0); PG8_MMA(0, 0, At, B0); PG8_BAR; PG8_SCHED;
            PG8_LDB(B1, 1, 1); PG8_STAGE(PG8_SB(1, 0), b3, voffB);
            PG8_BAR; PG8_WAIT_L(0); PG8_MMA(0, 1, At, B1); PG8_BAR;
            PG8_LDA(At, 1, 1); PG8_STAGE(PG8_SA(1, 0), a3, voffA);
            PG8_BAR; PG8_WAIT_L(0); PG8_MMA(1, 0, At, B0); PG8_BAR; PG8_SCHED;
            PG8_STAGE(PG8_SB(1, 1), b3 + hstep, voffB);
            PG8_WAIT_V(6); PG8_BAR; PG8_MMA(1, 1, At, B1); PG8_BAR;
            }
        }
        if constexpr (ALIGN_EPI) { if (wr == 0) PG8_BAR; }
        E(acc, cur, wr, wc, fr, fq); S.done(cur);
        if (!has_next) break;
#pragma unroll
        for (int a = 0; a < 2; ++a)
#pragma unroll
            for (int b = 0; b < 2; ++b)
#pragma unroll
                for (int m = 0; m < 4; ++m)
#pragma unroll
                    for (int n = 0; n < 2; ++n) acc[a][b][m][n] = (f32x4){0.f, 0.f, 0.f, 0.f};
        cur = nxt; cA = nA; cB = nB; ++ui;
        if constexpr (ALIGN_EPI) { if (wr == 1) PG8_BAR; }
    }
    PG8_WAIT_V(0);
    if constexpr (!ALIGN_EPI) { if (wr == 0) PG8_BAR; }
    PG8_BAR;
#undef PG8_SA
#undef PG8_SB
#undef PG8_STAGE
#undef PG8_LDA
#undef PG8_LDB
#undef PG8_MMA
#undef PG8_WAIT_V
#undef PG8_WAIT_L
#undef PG8_BAR
#undef PG8_SCHED
}
}


struct Epi1 {
    static constexpr bool PERM = true;
    bf16_t* act;
    template <int MODE> __device__ __forceinline__ void pair(const f32x4 (&acc)[2][2][4][2], bf16_t* O, int row0, int col0) const {
#pragma unroll
        for (int ai = 0; ai < 2; ++ai)
#pragma unroll
            for (int m = 0; m < 4; ++m) {
                float r[8];
#pragma unroll
                for (int n = 0; n < 2; ++n)
#pragma unroll
                    for (int j = 0; j < 4; ++j) { const float a = acc[ai][0][m][n][j], b = acc[ai][1][m][n][j];
                        r[4 * n + j] = MODE == 0 ? a * b : (MODE == 1 ? a * silu(b) : a * sigm(b)); }
                *(u32x4*)(O + (size_t)(row0 + ai * 128 + m * 16) * D + col0) = pack8(r);
            }
    }
    template <int MODE> __device__ __forceinline__ void single(const f32x4 (&acc)[2][2][4][2], bf16_t* O, int row0, int col0) const {
#pragma unroll
        for (int bj = 0; bj < 2; ++bj)
#pragma unroll
            for (int ai = 0; ai < 2; ++ai)
#pragma unroll
                for (int m = 0; m < 4; ++m) {
                    float r[8];
#pragma unroll
                    for (int j = 0; j < 4; ++j) { const float v0 = acc[ai][bj][m][0][j], v1 = acc[ai][bj][m][1][j];
                        r[j] = MODE == 0 ? silu(v0) : v0; r[4 + j] = MODE == 0 ? silu(v1) : v1; }
                    *(u32x4*)(O + (size_t)(row0 + ai * 128 + m * 16) * D + col0 + bj * 128) = pack8(r);
                }
    }
    __device__ __forceinline__ void operator()(const f32x4 (&acc)[2][2][4][2], const pg8::Unit& u, int wr, int wc, int fr, int fq) const {
        const int row0 = u.pm * 256 + wr * 64 + fr, tile = u.pn;
        if (tile < 24) {
            const int grp = tile >> 3, col0 = 128 * (tile & 7) + wc * 32 + 8 * fq;
            if (grp == 0) pair<0>(acc, act + 1 * (SLOT / 2), row0, col0);
            else if (grp == 1) pair<1>(acc, act + 2 * (SLOT / 2), row0, col0);
            else pair<2>(acc, act + 4 * (SLOT / 2), row0, col0);
        } else {
            const int t2 = tile - 24, g2 = t2 >> 2, col0 = 256 * (t2 & 3) + wc * 32 + 8 * fq;
            if (g2 == 0) single<0>(acc, act + 3 * (SLOT / 2), row0, col0);
            else single<1>(acc, act + (4 + g2) * (SLOT / 2), row0, col0);
        }
    }
};

struct EpiY {
    static constexpr bool PERM = true;
    bf16_t* Y;
    __device__ __forceinline__ void operator()(const f32x4 (&acc)[2][2][4][2], const pg8::Unit& u, int wr, int wc, int fr, int fq) const {
        const int row0 = u.pm * 256 + wr * 64 + fr, col0 = (u.pn & 3) * 256 + wc * 32 + 8 * fq;
#pragma unroll
        for (int bj = 0; bj < 2; ++bj)
#pragma unroll
            for (int ai = 0; ai < 2; ++ai)
#pragma unroll
                for (int m = 0; m < 4; ++m) {
                    float r[8];
#pragma unroll
                    for (int j = 0; j < 4; ++j) { r[j] = acc[ai][bj][m][0][j]; r[4 + j] = acc[ai][bj][m][1][j]; }
                    *(u32x4*)(Y + (size_t)(row0 + ai * 128 + m * 16) * D + col0 + bj * 128) = pack8(r);
                }
    }
};
struct EpiF {
    static constexpr bool PERM = false;
    float* out;
    __device__ __forceinline__ void operator()(const f32x4 (&acc)[2][2][4][2], const pg8::Unit& u, int wr, int wc, int fr, int fq) const {
        const int row0 = u.pm * 256 + wr * 64 + fr, col0 = u.pn * 256 + wc * 32 + 4 * fq;
#pragma unroll
        for (int ai = 0; ai < 2; ++ai)
#pragma unroll
            for (int m = 0; m < 4; ++m) { float* rowp = out + (size_t)(row0 + ai * 128 + m * 16) * D + col0;
#pragma unroll
                for (int bj = 0; bj < 2; ++bj)
#pragma unroll
                    for (int n = 0; n < 2; ++n) *(f32x4*)(rowp + bj * 128 + n * 16) = acc[ai][bj][m][n]; }
    }
};

__device__ __forceinline__ int w1_srccol(int nc) {
    const int tile = nc >> 8, within = nc & 255;
    if (tile < 24) { const int grp = tile >> 3, half = within >> 7, ch = 128 * (tile & 7) + (within & 127);
        const int split = grp == 0 ? (half ? 2 : 1) : (grp == 1 ? (half ? 3 : 0) : (half ? 5 : 4));
        return split * 1024 + ch; }
    const int t2 = tile - 24;
    return (6 + (t2 >> 2)) * 1024 + 256 * (t2 & 3) + within;
}
__device__ __forceinline__ void transpose_item(const float* W, int ldw, int srccol0, bf16_t* WT, int row0, int k0, LAS float* scr, int lane) {
#pragma unroll 8
    for (int i = 0; i < 32; ++i) { const int kk = 2 * i + (lane >> 5); scr[kk * 33 + (lane & 31)] = W[(size_t)(k0 + kk) * ldw + srccol0 + (lane & 31)]; }
    asm volatile("s_waitcnt lgkmcnt(0)" ::: "memory");
    const int c = lane & 7;
#pragma unroll
    for (int j = 0; j < 4; ++j) { const int n = (lane >> 3) + 8 * j; const LAS float* s = scr + (8 * c) * 33 + n;
        u32x4 o; o.x = cvt_pk_bf16(s[0 * 33], s[1 * 33]); o.y = cvt_pk_bf16(s[2 * 33], s[3 * 33]); o.z = cvt_pk_bf16(s[4 * 33], s[5 * 33]); o.w = cvt_pk_bf16(s[6 * 33], s[7 * 33]);
        *(u32x4*)(WT + (size_t)(row0 + n) * D + k0 + 8 * c) = o; }
    asm volatile("s_waitcnt lgkmcnt(0)" ::: "memory");
}
__device__ __forceinline__ void p0_phase(LAS unsigned char* lds, const float* c, const float* w_ada, const float* b_ada, const float* w_in, const float* w_out_a, const float* w_out_b,
                                         const float* w_o, unsigned char* ws, int G) {
    const int tid = threadIdx.x, lane = tid & 63, wave = tid >> 6;
    float* mod = (float*)(ws + WS_MOD);
    for (int item = blockIdx.x; item < 192; item += G) {
        LAS float* cact = (LAS float*)lds;
        LAS float* red = (LAS float*)(lds + 32768);
        for (int i = tid; i < NBATCH * D; i += 512) cact[i] = silu(c[i]);
        __syncthreads();
        const int col = tid & 15, kg = tid >> 4, j = item * 16 + col;
        float a[8];
#pragma unroll
        for (int b = 0; b < 8; ++b) a[b] = 0.f;
#pragma unroll 8
        for (int kk = 0; kk < 32; ++kk) { const int k = kg * 32 + kk; const float w = w_ada[(size_t)k * (3 * D) + j];
#pragma unroll
            for (int b = 0; b < 8; ++b) a[b] = fmaf(cact[b * D + k], w, a[b]); }
#pragma unroll
        for (int b = 0; b < 8; ++b) red[(b * 16 + col) * 33 + kg] = a[b];
        __syncthreads();
        if (tid < 128) { const int b = tid >> 4, cl = tid & 15; float s = 0.f;
            for (int q = 0; q < 32; ++q) s += red[(b * 16 + cl) * 33 + q];
            mod[b * 3 * D + item * 16 + cl] = s + b_ada[item * 16 + cl]; }
        __syncthreads();
    }
    LAS float* scr = (LAS float*)(lds + wave * 8448);
    const int gw = blockIdx.x * 8 + wave, NGW = G * 8;
    bf16_t* W1T = (bf16_t*)(ws + WS_W1T); bf16_t* WAB = (bf16_t*)(ws + WS_WAB); bf16_t* WOT = (bf16_t*)(ws + WS_WOT);
    constexpr int I1 = 16 * (DIN / 32), I2 = 16 * (D / 32);
    for (int it = gw; it < I1 + 3 * I2; it += NGW) {
        int r = it;
        if (r < I1) { const int kb = r / (DIN / 32), nb = r % (DIN / 32); transpose_item(w_in, DIN, w1_srccol(nb * 32), W1T, nb * 32, kb * 64, scr, lane); continue; }
        r -= I1;
        const int which = r / I2; r -= which * I2;
        const int kb = r / (D / 32), nb = r % (D / 32);
        if (which == 0) transpose_item(w_out_a, D, nb * 32, WAB, nb * 32, kb * 64, scr, lane);
        else if (which == 1) transpose_item(w_out_b, D, nb * 32, WAB, D + nb * 32, kb * 64, scr, lane);
        else transpose_item(w_o, D, nb * 32, WOT, nb * 32, kb * 64, scr, lane);
    }
}

__device__ __forceinline__ void p1_phase(const float* x, const float* gain, const float* mod, bf16_t* H, int G) {
    const int lane = threadIdx.x & 63, gw = blockIdx.x * 8 + (threadIdx.x >> 6), NGW = G * 8;
    for (int row = gw; row < M; row += NGW) {
        const f32x4* xr = (const f32x4*)(x + (size_t)row * D) + lane;
        f32x4 v[4]; float ss = 0.f;
#pragma unroll
        for (int j = 0; j < 4; ++j) { v[j] = xr[64 * j]; ss += (v[j].x * v[j].x + v[j].y * v[j].y) + (v[j].z * v[j].z + v[j].w * v[j].w); }
        const float r = rsqrtf(wave_sum(ss) * (1.f / D) + EPS);
        const float* shift = mod + (size_t)(row >> 12) * 3 * D; const float* scale = shift + D;
#pragma unroll
        for (int j = 0; j < 4; ++j) { const int cidx = 4 * lane + 256 * j;
            const f32x4 g = *(const f32x4*)(gain + cidx), sc = *(const f32x4*)(scale + cidx), sh = *(const f32x4*)(shift + cidx);
            const f32x4 h = (v[j] * r) * g * (1.0f + sc) + sh;
            u32x2 o; o.x = cvt_pk_bf16(h.x, h.y); o.y = cvt_pk_bf16(h.z, h.w);
            *(u32x2*)(H + (size_t)row * D + cidx) = o; }
    }
}

__device__ __forceinline__ void p3a_phase(const bf16_t* CV, bf16_t* BZ, const float* wa, int G) {
    const int gt = blockIdx.x * 512 + threadIdx.x, NT = G * 512;
    for (int item = gt; item < (M / 4) * (D / 8); item += NT) {
        const int tq = item >> 7, cb = (item & 127) * 8, t0 = tq * 4, p0 = t0 & (SEQ - 1);
        float w0[8], w1[8], w2[8];
        { const f32x4 a = *(const f32x4*)(wa + cb), b = *(const f32x4*)(wa + cb + 4), c2 = *(const f32x4*)(wa + D + cb), d = *(const f32x4*)(wa + D + cb + 4),
              e2 = *(const f32x4*)(wa + 2 * D + cb), f = *(const f32x4*)(wa + 2 * D + cb + 4);
#pragma unroll
          for (int e = 0; e < 4; ++e) { w0[e] = a[e]; w0[4 + e] = b[e]; w1[e] = c2[e]; w1[4 + e] = d[e]; w2[e] = e2[e]; w2[4 + e] = f[e]; } }
        u32x4 rows[6], bzr[4];
#pragma unroll
        for (int i = 0; i < 6; ++i) { const int pos = p0 - 1 + i; rows[i] = (u32x4){0u, 0u, 0u, 0u};
            if (pos >= 0 && pos < SEQ) rows[i] = *(const u32x4*)(CV + (size_t)(t0 - 1 + i) * D + cb); }
#pragma unroll
        for (int j = 0; j < 4; ++j) bzr[j] = *(const u32x4*)(BZ + (size_t)(t0 + j) * D + cb);
#pragma unroll
        for (int j = 0; j < 4; ++j) { float a[8], b[8], c[8], bz[8], r[8];
            unpack8(rows[j], a); unpack8(rows[j + 1], b); unpack8(rows[j + 2], c); unpack8(bzr[j], bz);
#pragma unroll
            for (int e = 0; e < 8; ++e) r[e] = bz[e] * (w0[e] * a[e] + w1[e] * b[e] + w2[e] * c[e]);
            *(u32x4*)(BZ + (size_t)(t0 + j) * D + cb) = pack8(r); }
    }
}
__device__ __forceinline__ void p3b_phase(LAS unsigned char* lds, bf16_t* SZ, const bf16_t* U, const float* wb, const float* cbias, const float* lng, const float* lnb, int G) {
    const int tid = threadIdx.x, co = tid & 31, tg = tid >> 5;
    LAS unsigned char* ut = lds;
    LAS unsigned char* wt = lds + 49152;
    for (int tile = blockIdx.x; tile < M / 64; tile += G) {
        const int t0 = tile * 64, p0 = t0 & (SEQ - 1);
        u32x4 pk[4][4];
        float s1[4], s2[4];
#pragma unroll
        for (int j = 0; j < 4; ++j) { s1[j] = 0.f; s2[j] = 0.f; }
#pragma unroll
        for (int ch = 0; ch < 4; ++ch) {
            __syncthreads();
            int c0 = ch * 256; asm volatile("" : "+s"(c0) :: "memory");
            const int cb = c0 + co * 8;
            {   const bf16_t* ug = U + (size_t)(t0 - 15 + tg) * D + c0 + co * 8; LAS unsigned char* ul = ut + tg * 512 + co * 16;
#pragma unroll
                for (int it = 0; it < 6; ++it) { const int r = it * 16 + tg, pos = p0 - 15 + r;
                    if (it < 5 || tg < 14) { u32x4 v = (u32x4){0u, 0u, 0u, 0u};
                        if (pos >= 0 && pos < SEQ) v = *(const u32x4*)(ug + (size_t)it * 16 * D);
                        *(LAS u32x4*)(ul + it * 8192) = v; } }
                const int wv = tid >> 6, cc = tid & 63;
                const float* wg = wb + (size_t)wv * D + c0 + cc * 4; LAS unsigned char* wl = wt + ((wv * 2 + (cc & 1)) * 32 + (cc >> 1)) * 16;
#pragma unroll
                for (int it = 0; it < 4; ++it) { if (it < 3 || wv < 7) *(LAS f32x4*)(wl + it * 8192) = *(const f32x4*)(wg + (size_t)it * 8 * D); } }
            __syncthreads();
            float acc[4][8];
            {   const f32x4 b0 = *(const f32x4*)(cbias + cb), b1 = *(const f32x4*)(cbias + cb + 4);
#pragma unroll
                for (int j = 0; j < 4; ++j)
#pragma unroll
                    for (int e = 0; e < 4; ++e) { acc[j][e] = b0[e]; acc[j][4 + e] = b1[e]; } }
            const LAS unsigned char* ub = ut + (tg * 4) * 512 + co * 16;
            const LAS unsigned char* wp = wt + co * 16;
#pragma unroll 1
            for (int k = 0; k < 30; k += 2) {
                float ur[5][8];
#pragma unroll
                for (int i = 0; i < 5; ++i) unpack8(*(const LAS u32x4*)(ub + (k + i) * 512), ur[i]);
                const f32x4 wa0 = *(const LAS f32x4*)(wp + k * 1024), wa1 = *(const LAS f32x4*)(wp + k * 1024 + 512);
                const f32x4 wb0 = *(const LAS f32x4*)(wp + k * 1024 + 1024), wb1 = *(const LAS f32x4*)(wp + k * 1024 + 1536);
#pragma unroll
                for (int j = 0; j < 4; ++j)
#pragma unroll
                    for (int e = 0; e < 4; ++e) {
                        acc[j][e] = fmaf(wb0[e], ur[j + 1][e], fmaf(wa0[e], ur[j][e], acc[j][e]));
                        acc[j][4 + e] = fmaf(wb1[e], ur[j + 1][4 + e], fmaf(wa1[e], ur[j][4 + e], acc[j][4 + e])); }
            }
            {   float ur[4][8];
#pragma unroll
                for (int i = 0; i < 4; ++i) unpack8(*(const LAS u32x4*)(ub + (30 + i) * 512), ur[i]);
                const f32x4 wa0 = *(const LAS f32x4*)(wp + 30 * 1024), wa1 = *(const LAS f32x4*)(wp + 30 * 1024 + 512);
#pragma unroll
                for (int j = 0; j < 4; ++j)
#pragma unroll
                    for (int e = 0; e < 4; ++e) { acc[j][e] = fmaf(wa0[e], ur[j][e], acc[j][e]); acc[j][4 + e] = fmaf(wa1[e], ur[j][4 + e], acc[j][4 + e]); }
            }
#pragma unroll
            for (int j = 0; j < 4; ++j) {
#pragma unroll
                for (int e = 0; e < 8; ++e) { s1[j] += acc[j][e]; s2[j] = fmaf(acc[j][e], acc[j][e], s2[j]); }
                pk[ch][j] = pack8(acc[j]); }
        }
        float mean[4], rstd[4];
#pragma unroll
        for (int j = 0; j < 4; ++j) { mean[j] = half_sum(s1[j]) * (1.f / D); const float ex2 = half_sum(s2[j]) * (1.f / D);
            rstd[j] = rsqrtf(fmaxf(ex2 - mean[j] * mean[j], 0.f) + EPS); }
#pragma unroll
        for (int ch = 0; ch < 4; ++ch) { int c0 = ch * 256; asm volatile("" : "+s"(c0) :: "memory"); const int cb = c0 + co * 8;
            float g[8], b[8];
            { const f32x4 g0 = *(const f32x4*)(lng + cb), g1 = *(const f32x4*)(lng + cb + 4), b0 = *(const f32x4*)(lnb + cb), b1 = *(const f32x4*)(lnb + cb + 4);
#pragma unroll
              for (int e = 0; e < 4; ++e) { g[e] = g0[e]; g[4 + e] = g1[e]; b[e] = b0[e]; b[4 + e] = b1[e]; } }
#pragma unroll
            for (int j = 0; j < 4; ++j) { const size_t off = (size_t)(t0 + tg * 4 + j) * D + cb;
                float sz[8], v[8], r[8]; unpack8(*(const u32x4*)(SZ + off), sz); unpack8(pk[ch][j], v);
#pragma unroll
                for (int e = 0; e < 8; ++e) { const float y = (v[e] - mean[j]) * rstd[j] * g[e] + b[e]; r[e] = silu(y) * sz[e]; }
                *(u32x4*)(SZ + off) = pack8(r); } }
    }
}

__device__ __forceinline__ void merge_phase(const bf16_t* MA, const bf16_t* MB, const bf16_t* YA, const bf16_t* YB, bf16_t* MG, const float* bmerge, const float* bob, int G) {
    const int gt = blockIdx.x * 512 + threadIdx.x, NT = G * 512;
    const int cb = (gt & 127) * 8;
    float ba[8], bb[8], bo[8];
    { const f32x4 a0 = *(const f32x4*)(bmerge + cb), a1 = *(const f32x4*)(bmerge + cb + 4), b0 = *(const f32x4*)(bmerge + D + cb), b1 = *(const f32x4*)(bmerge + D + cb + 4),
          c0 = *(const f32x4*)(bob + cb), c1 = *(const f32x4*)(bob + cb + 4);
#pragma unroll
      for (int e = 0; e < 4; ++e) { ba[e] = a0[e]; ba[4 + e] = a1[e]; bb[e] = b0[e]; bb[4 + e] = b1[e]; bo[e] = c0[e]; bo[4 + e] = c1[e]; } }
    for (size_t i = gt; i < (size_t)M * D / 8; i += NT) {
        float ma[8], mb[8], ya[8], yb[8], r[8];
        unpack8(*(const u32x4*)(MA + i * 8), ma); unpack8(*(const u32x4*)(MB + i * 8), mb); unpack8(*(const u32x4*)(YA + i * 8), ya); unpack8(*(const u32x4*)(YB + i * 8), yb);
#pragma unroll
        for (int e = 0; e < 8; ++e) r[e] = sigm(ma[e] + ba[e]) * ya[e] + sigm(mb[e] + bb[e]) * (yb[e] + bo[e]);
        *(u32x4*)(MG + i * 8) = pack8(r);
    }
}

__device__ __forceinline__ void p7_phase(float* out, const float* x, const float* mod, const float* fgain, int G) {
    const int lane = threadIdx.x & 63, gw = blockIdx.x * 8 + (threadIdx.x >> 6), NGW = G * 8;
    f32x4 g[4];
#pragma unroll
    for (int j = 0; j < 4; ++j) g[j] = *(const f32x4*)(fgain + 4 * lane + 256 * j);
    for (int row = gw; row < M; row += NGW) {
        f32x4* yr = (f32x4*)(out + (size_t)row * D) + lane; const f32x4* xr = (const f32x4*)(x + (size_t)row * D) + lane;
        const f32x4* gt = (const f32x4*)(mod + (size_t)(row >> 12) * 3 * D + 2 * D) + lane;
        f32x4 v[4]; float ss = 0.f;
#pragma unroll
        for (int j = 0; j < 4; ++j) { v[j] = xr[64 * j] + gt[64 * j] * yr[64 * j]; ss += (v[j].x * v[j].x + v[j].y * v[j].y) + (v[j].z * v[j].z + v[j].w * v[j].w); }
        const float r = rsqrtf(wave_sum(ss) * (1.f / D) + EPS);
#pragma unroll
        for (int j = 0; j < 4; ++j) yr[64 * j] = (v[j] * r) * g[j];
    }
}


#define XB_TMO      128
#define XB_XCNT(j)  (256  + 64 * (j))
#define XB_XSUB(j)  (1280 + 64 * (j))
#define XB_XGEN(j)  (2304 + 64 * (j))
#define XB_TOP      3328
#define XB_TOPGEN   3392
#define XCD_BAR_WORDS 3456
#define XB_SPIN_CAP (1u << 18)
__device__ __forceinline__ unsigned xb_ld(unsigned* p)              { return __hip_atomic_load(p, __ATOMIC_RELAXED, __HIP_MEMORY_SCOPE_AGENT); }
__device__ __forceinline__ unsigned xb_add(unsigned* p, unsigned v) { return __hip_atomic_fetch_add(p, v, __ATOMIC_RELAXED, __HIP_MEMORY_SCOPE_AGENT); }
__device__ __forceinline__ unsigned xb_xcc_id() { return (unsigned)__builtin_amdgcn_s_getreg((3 << 11) | 20) & 0xFu; }
#define XB_SPIN(cond, bar) do { unsigned _sp = 0; while (cond) { __builtin_amdgcn_s_sleep(1); \
    if ((++_sp & 255u) == 0u) { if (xb_ld(&(bar)[XB_TMO])) break; if (_sp > XB_SPIN_CAP) { atomicAdd(&(bar)[XB_TMO], 1u); break; } } } } while (0)
struct XcdBarrier { unsigned* bar; unsigned x; volatile LAS unsigned* st; };
__device__ __forceinline__ XcdBarrier xcd_barrier_post(unsigned* bar, volatile LAS unsigned* st) {
    XcdBarrier b; b.bar = bar; b.x = xb_xcc_id(); b.st = st;
    if (threadIdx.x == 0) (void)xb_add(&bar[XB_XCNT(b.x)], 1u);
    return b;
}
__device__ __forceinline__ void xcd_barrier_complete(unsigned* bar, unsigned x, unsigned& nloc, unsigned& nx) {
    const unsigned G = gridDim.x * gridDim.y * gridDim.z;
    unsigned sum, cnt, mine, sp = 0u;
    for (;;) {
        sum = 0u; cnt = 0u; mine = 0u;
#pragma unroll
        for (unsigned j = 0; j < 16; ++j) { const unsigned c = xb_ld(&bar[XB_XCNT(j)]); sum += c; cnt += (c > 0u) ? 1u : 0u; mine = (j == x) ? c : mine; }
        if (sum == G) break;
        __builtin_amdgcn_s_sleep(1);
        if ((++sp & 255u) == 0u) { if (xb_ld(&bar[XB_TMO])) break; if (sp > XB_SPIN_CAP) { atomicAdd(&bar[XB_TMO], 1u); break; } }
    }
    nloc = mine > 0u ? mine : 1u; nx = cnt > 0u ? cnt : 1u;
}
__device__ __forceinline__ void xcd_barrier(const XcdBarrier& b) {
    asm volatile("s_waitcnt vmcnt(0)" ::: "memory");
    __syncthreads();
    if (threadIdx.x == 0) {
        unsigned* bar = b.bar;
        __builtin_amdgcn_s_waitcnt(0);
        unsigned nloc = b.st[0], nx = b.st[1];
        if (nloc == 0u) { xcd_barrier_complete(bar, b.x, nloc, nx); b.st[0] = nloc; b.st[1] = nx; }
        const unsigned old = xb_add(&bar[XB_XSUB(b.x)], 1u);
        const unsigned gen = old / nloc;
        if (old + 1u == (gen + 1u) * nloc) {
            __builtin_amdgcn_fence(__ATOMIC_RELEASE, "agent");
            asm volatile("s_waitcnt vmcnt(0)" ::: "memory");
            const unsigned og = xb_add(&bar[XB_TOP], 1u);
            const unsigned tg = og / nx;
            if (og + 1u == (tg + 1u) * nx) xb_add(&bar[XB_TOPGEN], 1u);
            else XB_SPIN(xb_ld(&bar[XB_TOPGEN]) == tg, bar);
            __builtin_amdgcn_fence(__ATOMIC_ACQUIRE, "agent");
            xb_add(&bar[XB_XGEN(b.x)], 1u);
            asm volatile("s_waitcnt vmcnt(0)" ::: "memory");
        } else {
            XB_SPIN(xb_ld(&bar[XB_XGEN(b.x)]) == gen, bar);
            __builtin_amdgcn_fence(__ATOMIC_ACQUIRE, "agent");
            asm volatile("s_waitcnt vmcnt(0)" ::: "memory");
        }
    }
    __syncthreads();
}

struct Args { const float* in[17]; float* out; unsigned char* ws; int ph_lo, ph_hi; };

__global__ void __launch_bounds__(512, 2) fwd_kernel(Args a) {
    extern __shared__ __attribute__((aligned(16))) unsigned char shm[];
    LAS unsigned char* lds = (LAS unsigned char*)shm;
    cg::grid_group grid = cg::this_grid();
    const int G = gridDim.x, lo = a.ph_lo, hi = a.ph_hi;
    unsigned char* ws = a.ws;
    bf16_t* act = (bf16_t*)(ws + WS_ACT);
    const float* mod = (const float*)(ws + WS_MOD);
#define IN(k) (lo <= (k) && (k) < hi)
#define SEAM(k) do { if (IN(k) && IN((k) + 1)) { if ((k) == 0) grid.sync(); else xcd_barrier(xbar); } } while (0)
    volatile LAS unsigned* xst = (volatile LAS unsigned*)(lds + 131072);
    if (threadIdx.x < 4) xst[threadIdx.x] = 0u;
    __syncthreads();
    XcdBarrier xbar; xbar.bar = (unsigned*)(ws + WS_BAR); xbar.x = 0; xbar.st = xst;
    if (hi - lo > 1) xbar = xcd_barrier_post((unsigned*)(ws + WS_BAR), xst);
    if (IN(0)) p0_phase(lds, a.in[1], a.in[3], a.in[4], a.in[5], a.in[8], a.in[13], a.in[15], ws, G);
    SEAM(0);
    if (IN(1)) p1_phase(a.in[0], a.in[2], mod, act, G);
    SEAM(1);
    if (IN(2)) { pg8::Gemm g{act, (const bf16_t*)(ws + WS_W1T), M, DIN, D}; pg8::StaticOrder S; S.init(M, DIN, G, (int)blockIdx.x);
        Epi1 E{act}; pg8::gemm_phase<Epi1, pg8::StaticOrder, true, true>(lds, g, S, E); }
    SEAM(2);
    if (IN(3)) { p3a_phase(act + 1 * (SLOT / 2), act + 2 * (SLOT / 2), a.in[7], G);
        p3b_phase(lds, act + 3 * (SLOT / 2), act + 4 * (SLOT / 2), a.in[9], a.in[10], a.in[11], a.in[12], G); }
    SEAM(3);
    if (IN(4)) { pg8::Gemm g{act + 2 * (SLOT / 2), (const bf16_t*)(ws + WS_WAB), M, D, D}; pg8::PairOrder S; S.init(M, D, G, (int)blockIdx.x);
        EpiY E{act}; pg8::gemm_phase<EpiY, pg8::PairOrder, true, true>(lds, g, S, E); }
    SEAM(4);
    if (IN(5)) merge_phase(act + 5 * (SLOT / 2), act + 6 * (SLOT / 2), act, act + 1 * (SLOT / 2), act + 4 * (SLOT / 2), a.in[6], a.in[14], G);
    SEAM(5);
    if (IN(6)) { pg8::Gemm g{act + 4 * (SLOT / 2), (const bf16_t*)(ws + WS_WOT), M, D, D}; pg8::StaticOrder S; S.init(M, D, G, (int)blockIdx.x);
        EpiF E{a.out}; pg8::gemm_phase<EpiF, pg8::StaticOrder, true, true>(lds, g, S, E); }
    SEAM(6);
    if (IN(7)) p7_phase(a.out, a.in[0], mod, a.in[16], G);
#undef IN
#undef SEAM
}

extern "C" void kernel_launch(void* const* d_in, const int* in_sizes, int n_in, void* d_out, int out_size, void* d_ws, size_t ws_size, hipStream_t stream) {
    static int grid = 0;
    if (grid == 0) {
        if (n_in != 17 || out_size != M * D || ws_size < WS_END) { fprintf(stderr, "kernel_launch: unexpected shapes (n_in %d out %d ws %zu, need %zu)\n", n_in, out_size, ws_size, (size_t)WS_END); grid = -1; return; }
        int dev = 0, cus = 0, per_cu = 0;
        (void)hipGetDevice(&dev); (void)hipDeviceGetAttribute(&cus, hipDeviceAttributeMultiprocessorCount, dev);
        if (hipFuncSetAttribute((const void*)fwd_kernel, hipFuncAttributeMaxDynamicSharedMemorySize, LDS_BYTES) != hipSuccess) { fprintf(stderr, "kernel_launch: hipFuncSetAttribute failed\n"); grid = -1; return; }
        if (hipOccupancyMaxActiveBlocksPerMultiprocessor(&per_cu, (const void*)fwd_kernel, 512, LDS_BYTES) != hipSuccess || per_cu < 1) { fprintf(stderr, "kernel_launch: occupancy query says %d\n", per_cu); per_cu = 1; }
        (void)hipGetLastError();
        grid = cus;
    }
    if (grid < 0) return;
    Args a{};
    for (int i = 0; i < 17; ++i) a.in[i] = (const float*)d_in[i];
    a.out = (float*)d_out; a.ws = (unsigned char*)d_ws;
#if N_LAUNCHES == 1
    (void)hipMemsetAsync((char*)d_ws + WS_BAR, 0, XCD_BAR_WORDS * 4, stream);
    a.ph_lo = 0; a.ph_hi = 8;
    void* args[] = {&a};
    hipError_t e = hipLaunchCooperativeKernel((const void*)fwd_kernel, dim3(grid), dim3(512), args, LDS_BYTES, stream);
    if (e != hipSuccess) fprintf(stderr, "cooperative launch failed: %s (grid %d)\n", hipGetErrorString(e), grid);
#else
    for (int ph = 0; ph < 8; ++ph) { a.ph_lo = ph; a.ph_hi = ph + 1; hipLaunchKernelGGL(fwd_kernel, dim3(grid), dim3(512), LDS_BYTES, stream, a); }
#endif
}
```

```cpp
#include <hip/hip_runtime.h>
#include <hip/hip_cooperative_groups.h>
#include <cstdio>
namespace cg = cooperative_groups;

#ifndef N_LAUNCHES
#define N_LAUNCHES 1
#endif

#define LAS __attribute__((address_space(3)))
typedef unsigned short bf16_t;
typedef short bf16x8 __attribute__((ext_vector_type(8)));
typedef float f32x4 __attribute__((ext_vector_type(4)));
typedef unsigned u32x4 __attribute__((ext_vector_type(4)));
typedef unsigned u32x2 __attribute__((ext_vector_type(2)));

constexpr int D = 1024, NBATCH = 8, SEQ = 4096, M = NBATCH * SEQ, DIN = 9216;
constexpr float EPS = 1e-6f;
constexpr int LDS_BYTES = 131072 + 16;

constexpr size_t WS_W1T = 0;
constexpr size_t WS_WAB = WS_W1T + (size_t)DIN * D * 2;
constexpr size_t WS_WOT = WS_WAB + (size_t)2 * D * D * 2;
constexpr size_t WS_MOD = WS_WOT + (size_t)D * D * 2;
constexpr size_t WS_BAR = WS_MOD + 98304;
constexpr size_t WS_ACT = WS_MOD + 131072;
constexpr size_t SLOT = (size_t)M * D * 2;
constexpr size_t WS_END = WS_ACT + 7 * SLOT;

__device__ __forceinline__ float bflo(unsigned u) { return __uint_as_float(u << 16); }
__device__ __forceinline__ float bfhi(unsigned u) { return __uint_as_float(u & 0xffff0000u); }
__device__ __forceinline__ unsigned cvt_pk_bf16(float lo, float hi) { unsigned r; asm("v_cvt_pk_bf16_f32 %0, %1, %2" : "=v"(r) : "v"(lo), "v"(hi)); return r; }
__device__ __forceinline__ float sigm(float x) { return __builtin_amdgcn_rcpf(1.0f + __builtin_amdgcn_exp2f(-1.44269504f * x)); }
__device__ __forceinline__ float silu(float x) { return x * sigm(x); }
__device__ __forceinline__ void unpack8(const u32x4 v, float (&f)[8]) {
    f[0] = bflo(v.x); f[1] = bfhi(v.x); f[2] = bflo(v.y); f[3] = bfhi(v.y); f[4] = bflo(v.z); f[5] = bfhi(v.z); f[6] = bflo(v.w); f[7] = bfhi(v.w);
}
__device__ __forceinline__ u32x4 pack8(const float (&f)[8]) {
    u32x4 o; o.x = cvt_pk_bf16(f[0], f[1]); o.y = cvt_pk_bf16(f[2], f[3]); o.z = cvt_pk_bf16(f[4], f[5]); o.w = cvt_pk_bf16(f[6], f[7]); return o;
}
__device__ __forceinline__ float wave_sum(float v) {
#pragma unroll
    for (int o = 1; o < 64; o <<= 1) v += __shfl_xor(v, o);
    return v;
}
__device__ __forceinline__ float half_sum(float v) {
#pragma unroll
    for (int o = 1; o < 32; o <<= 1) v += __shfl_xor(v, o);
    return v;
}

namespace pg8 {
constexpr int BM = 256, BK = 64, HALF = 128, HTB = HALF * BK * 2, STAGE_BYTES = 8 * HTB, NXCD = 8, WGM = 8;
__host__ __device__ __forceinline__ int lds_byte(int r, int c) { const int st = (r >> 4) * 2 + (c >> 5), rr = r & 15, cc = c & 31, ob = rr * 64 + cc * 2; return st * 1024 + (ob ^ (((ob >> 9) & 1) << 5)); }
__host__ __device__ __forceinline__ void stage_rc(int b, int& R, int& C) { const int st = b / 1024, sb = b % 1024, swz = sb ^ (((sb >> 9) & 1) << 5); R = (st >> 1) * 16 + swz / 64; C = (st & 1) * 32 + (swz % 64) / 2; }
__host__ __device__ __forceinline__ int perm32(int rho) { const int n = rho >> 4, i = rho & 15; return 8 * (i >> 2) + 4 * n + (i & 3); }

struct Unit { int pm, pn; };
struct Gemm { const bf16_t* A; const bf16_t* Bt; int M, N, K; };

struct StaticOrder {
    int nM, nN, nwg, G, c;
    __device__ void init(int M_, int N_, int G_, int c_) { nM = M_ / BM; nN = N_ / BM; nwg = nM * nN; G = G_; c = c_; }
    __device__ bool map(long L, Unit& u) const {
        if (L >= nwg) return false;
        int wgid = (int)L; { const int q = nwg / NXCD, r = nwg % NXCD, xcd = wgid % NXCD, off = wgid / NXCD; wgid = (xcd < r ? xcd * (q + 1) : r * (q + 1) + (xcd - r) * q) + off; }
        const int nig = WGM * nN, gid = wgid / nig, fm = gid * WGM, gsz = (nM - fm) < WGM ? (nM - fm) : WGM;
        u.pm = fm + ((wgid % nig) % gsz); u.pn = (wgid % nig) / gsz; return true;
    }
    __device__ bool next(int i, Unit& u) const { return map((long)i * G + c, u); }
    __device__ __forceinline__ void a_ready(const Unit&) const {}
    __device__ __forceinline__ void done(const Unit&) const {}
};
struct PairOrder : StaticOrder {
    __device__ bool next(int i, Unit& u) const {
        const int j = i >> 1, h = i & 1;
        if (!map((long)j * G + c, u)) return false;
        u.pm += h * nM; u.pn += h * nN; return true;
    }
};

template <class Epi, class Sched, bool ALIGN_EPI = false, bool SP2 = false>
__device__ __forceinline__ void gemm_phase(LAS unsigned char* lds, const Gemm g, const Sched& S, const Epi& E) {
    const int tid = threadIdx.x, wid = __builtin_amdgcn_readfirstlane(tid >> 6), lane = tid & 63, wr = wid >> 2, wc = wid & 3, fr = lane & 15, fq = lane >> 4;
    const int K = g.K, nt = K / BK;
    unsigned voffA[2], voffB[2];
#pragma unroll
    for (int i = 0; i < 2; ++i) { int R, C; stage_rc(tid * 16 + i * 8192, R, C); const int Rb = Epi::PERM ? ((R & ~31) + perm32(R & 31)) : R;
        voffA[i] = (unsigned)(R * K + C) * 2u; voffB[i] = (unsigned)(Rb * K + C) * 2u; }
    const size_t kstep = (size_t)(BK * 2);
    const size_t hstep = (size_t)HALF * K * 2;
    const size_t tstep = 2 * hstep;
    const unsigned ldsw = (unsigned)wid * 1024u;
    const int aoff = lds_byte(wr * 64 + fr, fq * 8), boff = lds_byte(wc * 32 + fr, fq * 8);
#define PG8_SA(b, h) (((b) * 2 + (h)) * HTB)
#define PG8_SB(b, h) ((4 + (b) * 2 + (h)) * HTB)
#define PG8_STAGE(bufoff, gbase, voff) do { _Pragma("unroll") for (int _i = 0; _i < 2; ++_i) \
        __builtin_amdgcn_global_load_lds((const unsigned*)((const char*)(gbase) + (voff)[_i]), (LAS unsigned*)(lds + (bufoff) + ldsw + _i * 8192), 16, 0, 0); } while (0)
#define PG8_LDA(dst, b, h) do { _Pragma("unroll") for (int m = 0; m < 4; ++m) _Pragma("unroll") for (int k = 0; k < 2; ++k) dst[m][k] = *(const LAS bf16x8*)(lds + PG8_SA(b, h) + aoff + m * 2048 + k * 1024); } while (0)
#define PG8_LDB(dst, b, h) do { _Pragma("unroll") for (int n = 0; n < 2; ++n) _Pragma("unroll") for (int k = 0; k < 2; ++k) dst[n][k] = *(const LAS bf16x8*)(lds + PG8_SB(b, h) + boff + n * 2048 + k * 1024); } while (0)
#define PG8_MMA(ai, bj, At, Bt) do { __builtin_amdgcn_s_setprio(1); _Pragma("unroll") for (int m = 0; m < 4; ++m) _Pragma("unroll") for (int n = 0; n < 2; ++n) _Pragma("unroll") for (int k = 0; k < 2; ++k) \
        acc[ai][bj][m][n] = __builtin_amdgcn_mfma_f32_16x16x32_bf16(Bt[n][k], At[m][k], acc[ai][bj][m][n], 0, 0, 0); __builtin_amdgcn_s_setprio(0); } while (0)
#define PG8_WAIT_V(n) asm volatile("s_waitcnt vmcnt(" #n ")" ::: "memory")
#define PG8_WAIT_L(n) asm volatile("s_waitcnt lgkmcnt(" #n ")" ::: "memory")
#define PG8_BAR __builtin_amdgcn_s_barrier()
#define PG8_SCHED __builtin_amdgcn_sched_barrier(0)
    Unit cur, nxt; int ui = 0;
    if (!S.next(0, cur)) return;
    f32x4 acc[2][2][4][2];
#pragma unroll
    for (int a = 0; a < 2; ++a)
#pragma unroll
        for (int b = 0; b < 2; ++b)
#pragma unroll
            for (int m = 0; m < 4; ++m)
#pragma unroll
                for (int n = 0; n < 2; ++n) acc[a][b][m][n] = (f32x4){0.f, 0.f, 0.f, 0.f};
    bf16x8 At[4][2], B0[2][2], B1[2][2];
    const char* cA = (const char*)g.A + (size_t)cur.pm * tstep; const char* cB = (const char*)g.Bt + (size_t)cur.pn * tstep;
    S.a_ready(cur);
    if constexpr (SP2) {
        PG8_STAGE(PG8_SB(0, 0), cB, voffB); PG8_STAGE(PG8_SB(0, 1), cB + hstep, voffB); PG8_STAGE(PG8_SA(0, 0), cA, voffA); PG8_STAGE(PG8_SA(0, 1), cA + hstep, voffA);
        if (wr == 1) PG8_BAR;
        PG8_WAIT_V(2); PG8_BAR;
        PG8_STAGE(PG8_SB(1, 0), cB + kstep, voffB); PG8_STAGE(PG8_SA(1, 0), cA + kstep, voffA); PG8_STAGE(PG8_SB(1, 1), cB + hstep + kstep, voffB);
        PG8_WAIT_V(6); PG8_BAR;
    } else {
        PG8_STAGE(PG8_SB(0, 0), cB, voffB); PG8_STAGE(PG8_SA(0, 0), cA, voffA); PG8_STAGE(PG8_SB(0, 1), cB + hstep, voffB); PG8_STAGE(PG8_SA(0, 1), cA + hstep, voffA);
        if (wr == 1) PG8_BAR;
        PG8_WAIT_V(4); PG8_BAR;
        PG8_STAGE(PG8_SB(1, 0), cB + kstep, voffB); PG8_STAGE(PG8_SA(1, 0), cA + kstep, voffA); PG8_STAGE(PG8_SB(1, 1), cB + hstep + kstep, voffB);
        PG8_WAIT_V(6); PG8_BAR;
    }
    for (;;) {
        const bool has_next = S.next(ui + 1, nxt);
        const char* nA = has_next ? (const char*)g.A + (size_t)nxt.pm * tstep : cA; const char* nB = has_next ? (const char*)g.Bt + (size_t)nxt.pn * tstep : cB;
        for (int t = 0; t < nt; t += 2) {
            const bool last = (t == nt - 2);
            const char* a1 = cA + (size_t)(t + 1) * kstep;
            const char* a2 = last ? nA : cA + (size_t)(t + 2) * kstep; const char* b2 = last ? nB : cB + (size_t)(t + 2) * kstep;
            const char* a3 = a2 + kstep; const char* b3 = b2 + kstep;
            if (last && has_next) S.a_ready(nxt);
            if constexpr (SP2) {
            PG8_LDB(B0, 0, 0); PG8_LDB(B1, 0, 1); PG8_SCHED; PG8_LDA(At, 0, 0); PG8_STAGE(PG8_SA(1, 1), a1 + hstep, voffA);
            PG8_WAIT_V(8); PG8_WAIT_L(0); PG8_BAR; PG8_MMA(0, 0, At, B0); PG8_MMA(0, 1, At, B1); PG8_BAR; PG8_SCHED;
            PG8_LDA(At, 0, 1); PG8_STAGE(PG8_SB(0, 0), b2, voffB); PG8_STAGE(PG8_SB(0, 1), b2 + hstep, voffB); PG8_STAGE(PG8_SA(0, 0), a2, voffA);
            PG8_WAIT_V(8); PG8_WAIT_L(0); PG8_BAR; PG8_MMA(1, 0, At, B0); PG8_MMA(1, 1, At, B1); PG8_BAR; PG8_SCHED;
            PG8_LDB(B0, 1, 0); PG8_LDB(B1, 1, 1); PG8_SCHED; PG8_LDA(At, 1, 0); PG8_STAGE(PG8_SA(0, 1), a2 + hstep, voffA);
            PG8_WAIT_V(8); PG8_WAIT_L(0); PG8_BAR; PG8_MMA(0, 0, At, B0); PG8_MMA(0, 1, At, B1); PG8_BAR; PG8_SCHED;
            PG8_LDA(At, 1, 1); PG8_STAGE(PG8_SB(1, 0), b3, voffB); PG8_STAGE(PG8_SB(1, 1), b3 + hstep, voffB); PG8_STAGE(PG8_SA(1, 0), a3, voffA);
            PG8_WAIT_V(8); PG8_WAIT_L(0); PG8_BAR; PG8_MMA(1, 0, At, B0); PG8_MMA(1, 1, At, B1); PG8_BAR; PG8_SCHED;
            } else {
            PG8_LDB(B0, 0, 0); PG8_SCHED; PG8_LDA(At, 0, 0); PG8_STAGE(PG8_SA(1, 1), a1 + hstep, voffA);
            PG8_WAIT_L(8); PG8_BAR; PG8_WAIT_L(0); PG8_MMA(0, 0, At, B0); PG8_BAR; PG8_SCHED;
            PG8_LDB(B1, 0, 1); PG8_STAGE(PG8_SB(0, 0), b2, voffB);
            PG8_BAR; PG8_WAIT_L(0); PG8_MMA(0, 1, At, B1); PG8_BAR;
            PG8_LDA(At, 0, 1); PG8_STAGE(PG8_SA(0, 0), a2, voffA);
            PG8_BAR; PG8_WAIT_L(0); PG8_MMA(1, 0, At, B0); PG8_BAR; PG8_SCHED;
            PG8_STAGE(PG8_SB(0, 1), b2 + hstep, voffB);
            PG8_WAIT_V(6); PG8_BAR; PG8_MMA(1, 1, At, B1); PG8_BAR;
            PG8_LDB(B0, 1, 0); PG8_SCHED; PG8_LDA(At, 1, 0); PG8_STAGE(PG8_SA(0, 1), a2 + hstep, voffA);
            PG8_WAIT_L(8); PG8_BAR; PG8_WAIT_L(0); PG8_MMA(0, 0, At, B0); PG8_BAR; PG8_SCHED;
            PG8_LDB(B1, 1, 1); PG8_STAGE(PG8_SB(1, 0), b3, voffB);
            PG8_BAR; PG8_WAIT_L(0); PG8_MMA(0, 1, At, B1); PG8_BAR;
            PG8_LDA(At, 1, 1); PG8_STAGE(PG8_SA(1, 0), a3, voffA);
            PG8_BAR; PG8_WAIT_L(0); PG8_MMA(1, 0, At, B0); PG8_BAR; PG8_SCHED;
            PG8_STAGE(PG8_SB(1, 1), b3 + hstep, voffB);
            PG8_WAIT_V(6); PG8_BAR; PG8_MMA(1, 1, At, B1); PG8_BAR;
            }
        }
        if constexpr (ALIGN_EPI) { if (wr == 0) PG8_BAR; }
        E(acc, cur, wr, wc, fr, fq); S.done(cur);
        if (!has_next) break;
#pragma unroll
        for (int a = 0; a < 2; ++a)
#pragma unroll
            for (int b = 0; b < 2; ++b)
#pragma unroll
                for (int m = 0; m < 4; ++m)
#pragma unroll
                    for (int n = 0; n < 2; ++n) acc[a][b][m][n] = (f32x4){0.f, 0.f, 0.f, 0.f};
        cur = nxt; cA = nA; cB = nB; ++ui;
        if constexpr (ALIGN_EPI) { if (wr == 1) PG8_BAR; }
    }
    PG8_WAIT_V(0);
    if constexpr (!ALIGN_EPI) { if (wr == 0) PG8_BAR; }
    PG8_BAR;
#undef PG8_SA
#undef PG8_SB
#undef PG8_STAGE
#undef PG8_LDA
#undef PG8_LDB
#undef PG8_MMA
#undef PG8_WAIT_V
#undef PG8_WAIT_L
#undef PG8_BAR
#undef PG8_SCHED
}
}


struct Epi1 {
    static constexpr bool PERM = true;
    bf16_t* act;
    template <int MODE> __device__ __forceinline__ void pair(const f32x4 (&acc)[2][2][4][2], bf16_t* O, int row0, int col0) const {
#pragma unroll
        for (int ai = 0; ai < 2; ++ai)
#pragma unroll
            for (int m = 0; m < 4; ++m) {
                float r[8];
#pragma unroll
                for (int n = 0; n < 2; ++n)
#pragma unroll
                    for (int j = 0; j < 4; ++j) { const float a = acc[ai][0][m][n][j], b = acc[ai][1][m][n][j];
                        r[4 * n + j] = MODE == 0 ? a * b : (MODE == 1 ? a * silu(b) : a * sigm(b)); }
                *(u32x4*)(O + (size_t)(row0 + ai * 128 + m * 16) * D + col0) = pack8(r);
            }
    }
    template <int MODE> __device__ __forceinline__ void single(const f32x4 (&acc)[2][2][4][2], bf16_t* O, int row0, int col0) const {
#pragma unroll
        for (int bj = 0; bj < 2; ++bj)
#pragma unroll
            for (int ai = 0; ai < 2; ++ai)
#pragma unroll
                for (int m = 0; m < 4; ++m) {
                    float r[8];
#pragma unroll
                    for (int j = 0; j < 4; ++j) { const float v0 = acc[ai][bj][m][0][j], v1 = acc[ai][bj][m][1][j];
                        r[j] = MODE == 0 ? silu(v0) : v0; r[4 + j] = MODE == 0 ? silu(v1) : v1; }
                    *(u32x4*)(O + (size_t)(row0 + ai * 128 + m * 16) * D + col0 + bj * 128) = pack8(r);
                }
    }
    __device__ __forceinline__ void operator()(const f32x4 (&acc)[2][2][4][2], const pg8::Unit& u, int wr, int wc, int fr, int fq) const {
        const int row0 = u.pm * 256 + wr * 64 + fr, tile = u.pn;
        if (tile < 24) {
            const int grp = tile >> 3, col0 = 128 * (tile & 7) + wc * 32 + 8 * fq;
            if (grp == 0) pair<0>(acc, act + 1 * (SLOT / 2), row0, col0);
            else if (grp == 1) pair<1>(acc, act + 2 * (SLOT / 2), row0, col0);
            else pair<2>(acc, act + 4 * (SLOT / 2), row0, col0);
        } else {
            const int t2 = tile - 24, g2 = t2 >> 2, col0 = 256 * (t2 & 3) + wc * 32 + 8 * fq;
            if (g2 == 0) single<0>(acc, act + 3 * (SLOT / 2), row0, col0);
            else single<1>(acc, act + (4 + g2) * (SLOT / 2), row0, col0);
        }
    }
};

struct EpiY {
    static constexpr bool PERM = true;
    bf16_t* Y;
    __device__ __forceinline__ void operator()(const f32x4 (&acc)[2][2][4][2], const pg8::Unit& u, int wr, int wc, int fr, int fq) const {
        const int row0 = u.pm * 256 + wr * 64 + fr, col0 = (u.pn & 3) * 256 + wc * 32 + 8 * fq;
#pragma unroll
        for (int bj = 0; bj < 2; ++bj)
#pragma unroll
            for (int ai = 0; ai < 2; ++ai)
#pragma unroll
                for (int m = 0; m < 4; ++m) {
                    float r[8];
#pragma unroll
                    for (int j = 0; j < 4; ++j) { r[j] = acc[ai][bj][m][0][j]; r[4 + j] = acc[ai][bj][m][1][j]; }
                    *(u32x4*)(Y + (size_t)(row0 + ai * 128 + m * 16) * D + col0 + bj * 128) = pack8(r);
                }
    }
};
__device__ __forceinline__ int w1_srccol(int nc) {
    const int tile = nc >> 8, within = nc & 255;
    if (tile < 24) { const int grp = tile >> 3, half = within >> 7, ch = 128 * (tile & 7) + (within & 127);
        const int split = grp == 0 ? (half ? 2 : 1) : (grp == 1 ? (half ? 3 : 0) : (half ? 5 : 4));
        return split * 1024 + ch; }
    const int t2 = tile - 24;
    return (6 + (t2 >> 2)) * 1024 + 256 * (t2 & 3) + within;
}
__device__ __forceinline__ void transpose_item(const float* W, int ldw, int srccol0, bf16_t* WT, int row0, int k0, LAS float* scr, int lane) {
#pragma unroll 8
    for (int i = 0; i < 32; ++i) { const int kk = 2 * i + (lane >> 5); scr[kk * 33 + (lane & 31)] = W[(size_t)(k0 + kk) * ldw + srccol0 + (lane & 31)]; }
    asm volatile("s_waitcnt lgkmcnt(0)" ::: "memory");
    const int c = lane & 7;
#pragma unroll
    for (int j = 0; j < 4; ++j) { const int n = (lane >> 3) + 8 * j; const LAS float* s = scr + (8 * c) * 33 + n;
        u32x4 o; o.x = cvt_pk_bf16(s[0 * 33], s[1 * 33]); o.y = cvt_pk_bf16(s[2 * 33], s[3 * 33]); o.z = cvt_pk_bf16(s[4 * 33], s[5 * 33]); o.w = cvt_pk_bf16(s[6 * 33], s[7 * 33]);
        *(u32x4*)(WT + (size_t)(row0 + n) * D + k0 + 8 * c) = o; }
    asm volatile("s_waitcnt lgkmcnt(0)" ::: "memory");
}
__device__ __forceinline__ void p0_phase(LAS unsigned char* lds, const float* c, const float* w_ada, const float* b_ada, const float* w_in, const float* w_out_a, const float* w_out_b,
                                         const float* w_o, unsigned char* ws, int G) {
    const int tid = threadIdx.x, lane = tid & 63, wave = tid >> 6;
    float* mod = (float*)(ws + WS_MOD);
    for (int item = blockIdx.x; item < 192; item += G) {
        LAS float* cact = (LAS float*)lds;
        LAS float* red = (LAS float*)(lds + 32768);
        for (int i = tid; i < NBATCH * D; i += 512) cact[i] = silu(c[i]);
        __syncthreads();
        const int col = tid & 15, kg = tid >> 4, j = item * 16 + col;
        float a[8];
#pragma unroll
        for (int b = 0; b < 8; ++b) a[b] = 0.f;
#pragma unroll 8
        for (int kk = 0; kk < 32; ++kk) { const int k = kg * 32 + kk; const float w = w_ada[(size_t)k * (3 * D) + j];
#pragma unroll
            for (int b = 0; b < 8; ++b) a[b] = fmaf(cact[b * D + k], w, a[b]); }
#pragma unroll
        for (int b = 0; b < 8; ++b) red[(b * 16 + col) * 33 + kg] = a[b];
        __syncthreads();
        if (tid < 128) { const int b = tid >> 4, cl = tid & 15; float s = 0.f;
            for (int q = 0; q < 32; ++q) s += red[(b * 16 + cl) * 33 + q];
            mod[b * 3 * D + item * 16 + cl] = s + b_ada[item * 16 + cl]; }
        __syncthreads();
    }
    LAS float* scr = (LAS float*)(lds + wave * 8448);
    const int gw = blockIdx.x * 8 + wave, NGW = G * 8;
    bf16_t* W1T = (bf16_t*)(ws + WS_W1T); bf16_t* WAB = (bf16_t*)(ws + WS_WAB); bf16_t* WOT = (bf16_t*)(ws + WS_WOT);
    constexpr int I1 = 16 * (DIN / 32), I2 = 16 * (D / 32);
    for (int it = gw; it < I1 + 3 * I2; it += NGW) {
        int r = it;
        if (r < I1) { const int kb = r / (DIN / 32), nb = r % (DIN / 32); transpose_item(w_in, DIN, w1_srccol(nb * 32), W1T, nb * 32, kb * 64, scr, lane); continue; }
        r -= I1;
        const int which = r / I2; r -= which * I2;
        const int kb = r / (D / 32), nb = r % (D / 32);
        if (which == 0) transpose_item(w_out_a, D, nb * 32, WAB, nb * 32, kb * 64, scr, lane);
        else if (which == 1) transpose_item(w_out_b, D, nb * 32, WAB, D + nb * 32, kb * 64, scr, lane);
        else transpose_item(w_o, D, nb * 32, WOT, nb * 32, kb * 64, scr, lane);
    }
}

__device__ __forceinline__ void p1_phase(const float* x, const float* gain, const float* mod, bf16_t* H, int G) {
    const int lane = threadIdx.x & 63, gw = blockIdx.x * 8 + (threadIdx.x >> 6), NGW = G * 8;
    for (int row0 = gw; row0 < M; row0 += 2 * NGW) {
        f32x4 v[2][4]; float ss[2];
#pragma unroll
        for (int q = 0; q < 2; ++q) { const f32x4* xr = (const f32x4*)(x + (size_t)(row0 + q * NGW) * D) + lane; ss[q] = 0.f;
#pragma unroll
            for (int j = 0; j < 4; ++j) v[q][j] = xr[64 * j]; }
#pragma unroll
        for (int q = 0; q < 2; ++q) {
#pragma unroll
            for (int j = 0; j < 4; ++j) ss[q] += (v[q][j].x * v[q][j].x + v[q][j].y * v[q][j].y) + (v[q][j].z * v[q][j].z + v[q][j].w * v[q][j].w); }
#pragma unroll
        for (int q = 0; q < 2; ++q) { const int row = row0 + q * NGW;
            const float r = rsqrtf(wave_sum(ss[q]) * (1.f / D) + EPS);
            const float* shift = mod + (size_t)(row >> 12) * 3 * D; const float* scale = shift + D;
#pragma unroll
            for (int j = 0; j < 4; ++j) { const int cidx = 4 * lane + 256 * j;
                const f32x4 g = *(const f32x4*)(gain + cidx), sc = *(const f32x4*)(scale + cidx), sh = *(const f32x4*)(shift + cidx);
                const f32x4 h = (v[q][j] * r) * g * (1.0f + sc) + sh;
                u32x2 o; o.x = cvt_pk_bf16(h.x, h.y); o.y = cvt_pk_bf16(h.z, h.w);
                *(u32x2*)(H + (size_t)row * D + cidx) = o; } }
    }
}

__device__ __forceinline__ void p3a_phase(const bf16_t* CV, bf16_t* BZ, const float* wa, int G) {
    const int gt = blockIdx.x * 512 + threadIdx.x, NT = G * 512;
    for (int item = gt; item < (M / 4) * (D / 8); item += NT) {
        const int tq = item >> 7, cb = (item & 127) * 8, t0 = tq * 4, p0 = t0 & (SEQ - 1);
        float w0[8], w1[8], w2[8];
        { const f32x4 a = *(const f32x4*)(wa + cb), b = *(const f32x4*)(wa + cb + 4), c2 = *(const f32x4*)(wa + D + cb), d = *(const f32x4*)(wa + D + cb + 4),
              e2 = *(const f32x4*)(wa + 2 * D + cb), f = *(const f32x4*)(wa + 2 * D + cb + 4);
#pragma unroll
          for (int e = 0; e < 4; ++e) { w0[e] = a[e]; w0[4 + e] = b[e]; w1[e] = c2[e]; w1[4 + e] = d[e]; w2[e] = e2[e]; w2[4 + e] = f[e]; } }
        u32x4 rows[6], bzr[4];
#pragma unroll
        for (int i = 0; i < 6; ++i) { const int pos = p0 - 1 + i; rows[i] = (u32x4){0u, 0u, 0u, 0u};
            if (pos >= 0 && pos < SEQ) rows[i] = *(const u32x4*)(CV + (size_t)(t0 - 1 + i) * D + cb); }
#pragma unroll
        for (int j = 0; j < 4; ++j) bzr[j] = *(const u32x4*)(BZ + (size_t)(t0 + j) * D + cb);
#pragma unroll
        for (int j = 0; j < 4; ++j) { float a[8], b[8], c[8], bz[8], r[8];
            unpack8(rows[j], a); unpack8(rows[j + 1], b); unpack8(rows[j + 2], c); unpack8(bzr[j], bz);
#pragma unroll
            for (int e = 0; e < 8; ++e) r[e] = bz[e] * (w0[e] * a[e] + w1[e] * b[e] + w2[e] * c[e]);
            *(u32x4*)(BZ + (size_t)(t0 + j) * D + cb) = pack8(r); }
    }
}
__device__ __forceinline__ void p3b_phase(LAS unsigned char* lds, bf16_t* SZ, const bf16_t* U, const float* wb, const float* cbias, const float* lng, const float* lnb, int G) {
    const int tid = threadIdx.x, co = tid & 31, tg = tid >> 5;
    LAS unsigned char* ut = lds;
    LAS unsigned char* wt = lds + 49152;
    for (int tile = blockIdx.x; tile < M / 64; tile += G) {
        const int t0 = tile * 64, p0 = t0 & (SEQ - 1);
        u32x4 pk[4][4];
        float s1[4], s2[4];
#pragma unroll
        for (int j = 0; j < 4; ++j) { s1[j] = 0.f; s2[j] = 0.f; }
#pragma unroll
        for (int ch = 0; ch < 4; ++ch) {
            __syncthreads();
            int c0 = ch * 256; asm volatile("" : "+s"(c0) :: "memory");
            const int cb = c0 + co * 8;
            {   const bf16_t* ug = U + (size_t)(t0 - 15 + tg) * D + c0 + co * 8; LAS unsigned char* ul = ut + tg * 512 + co * 16;
#pragma unroll
                for (int it = 0; it < 6; ++it) { const int r = it * 16 + tg, pos = p0 - 15 + r;
                    if (it < 5 || tg < 14) { u32x4 v = (u32x4){0u, 0u, 0u, 0u};
                        if (pos >= 0 && pos < SEQ) v = *(const u32x4*)(ug + (size_t)it * 16 * D);
                        *(LAS u32x4*)(ul + it * 8192) = v; } }
                const int wv = tid >> 6, cc = tid & 63;
                const float* wg = wb + (size_t)wv * D + c0 + cc * 4; LAS unsigned char* wl = wt + ((wv * 2 + (cc & 1)) * 32 + (cc >> 1)) * 16;
#pragma unroll
                for (int it = 0; it < 4; ++it) { if (it < 3 || wv < 7) *(LAS f32x4*)(wl + it * 8192) = *(const f32x4*)(wg + (size_t)it * 8 * D); } }
            __syncthreads();
            float acc[4][8];
            {   const f32x4 b0 = *(const f32x4*)(cbias + cb), b1 = *(const f32x4*)(cbias + cb + 4);
#pragma unroll
                for (int j = 0; j < 4; ++j)
#pragma unroll
                    for (int e = 0; e < 4; ++e) { acc[j][e] = b0[e]; acc[j][4 + e] = b1[e]; } }
            const LAS unsigned char* ub = ut + (tg * 4) * 512 + co * 16;
            const LAS unsigned char* wp = wt + co * 16;
#pragma unroll 1
            for (int k = 0; k < 30; k += 2) {
                float ur[5][8];
#pragma unroll
                for (int i = 0; i < 5; ++i) unpack8(*(const LAS u32x4*)(ub + (k + i) * 512), ur[i]);
                const f32x4 wa0 = *(const LAS f32x4*)(wp + k * 1024), wa1 = *(const LAS f32x4*)(wp + k * 1024 + 512);
                const f32x4 wb0 = *(const LAS f32x4*)(wp + k * 1024 + 1024), wb1 = *(const LAS f32x4*)(wp + k * 1024 + 1536);
#pragma unroll
                for (int j = 0; j < 4; ++j)
#pragma unroll
                    for (int e = 0; e < 4; ++e) {
                        acc[j][e] = fmaf(wb0[e], ur[j + 1][e], fmaf(wa0[e], ur[j][e], acc[j][e]));
                        acc[j][4 + e] = fmaf(wb1[e], ur[j + 1][4 + e], fmaf(wa1[e], ur[j][4 + e], acc[j][4 + e])); }
            }
            {   float ur[4][8];
#pragma unroll
                for (int i = 0; i < 4; ++i) unpack8(*(const LAS u32x4*)(ub + (30 + i) * 512), ur[i]);
                const f32x4 wa0 = *(const LAS f32x4*)(wp + 30 * 1024), wa1 = *(const LAS f32x4*)(wp + 30 * 1024 + 512);
#pragma unroll
                for (int j = 0; j < 4; ++j)
#pragma unroll
                    for (int e = 0; e < 4; ++e) { acc[j][e] = fmaf(wa0[e], ur[j][e], acc[j][e]); acc[j][4 + e] = fmaf(wa1[e], ur[j][4 + e], acc[j][4 + e]); }
            }
#pragma unroll
            for (int j = 0; j < 4; ++j) {
#pragma unroll
                for (int e = 0; e < 8; ++e) { s1[j] += acc[j][e]; s2[j] = fmaf(acc[j][e], acc[j][e], s2[j]); }
                pk[ch][j] = pack8(acc[j]); }
        }
        float mean[4], rstd[4];
#pragma unroll
        for (int j = 0; j < 4; ++j) { mean[j] = half_sum(s1[j]) * (1.f / D); const float ex2 = half_sum(s2[j]) * (1.f / D);
            rstd[j] = rsqrtf(fmaxf(ex2 - mean[j] * mean[j], 0.f) + EPS); }
#pragma unroll
        for (int ch = 0; ch < 4; ++ch) { int c0 = ch * 256; asm volatile("" : "+s"(c0) :: "memory"); const int cb = c0 + co * 8;
            float g[8], b[8];
            { const f32x4 g0 = *(const f32x4*)(lng + cb), g1 = *(const f32x4*)(lng + cb + 4), b0 = *(const f32x4*)(lnb + cb), b1 = *(const f32x4*)(lnb + cb + 4);
#pragma unroll
              for (int e = 0; e < 4; ++e) { g[e] = g0[e]; g[4 + e] = g1[e]; b[e] = b0[e]; b[4 + e] = b1[e]; } }
#pragma unroll
            for (int j = 0; j < 4; ++j) { const size_t off = (size_t)(t0 + tg * 4 + j) * D + cb;
                float sz[8], v[8], r[8]; unpack8(*(const u32x4*)(SZ + off), sz); unpack8(pk[ch][j], v);
#pragma unroll
                for (int e = 0; e < 8; ++e) { const float y = (v[e] - mean[j]) * rstd[j] * g[e] + b[e]; r[e] = silu(y) * sz[e]; }
                *(u32x4*)(SZ + off) = pack8(r); } }
    }
}

__device__ __forceinline__ void merge_phase(const bf16_t* MA, const bf16_t* MB, const bf16_t* YA, const bf16_t* YB, bf16_t* MG, const float* bmerge, const float* bob, int G) {
    const int gt = blockIdx.x * 512 + threadIdx.x, NT = G * 512;
    const int cb = (gt & 127) * 8;
    float ba[8], bb[8], bo[8];
    { const f32x4 a0 = *(const f32x4*)(bmerge + cb), a1 = *(const f32x4*)(bmerge + cb + 4), b0 = *(const f32x4*)(bmerge + D + cb), b1 = *(const f32x4*)(bmerge + D + cb + 4),
          c0 = *(const f32x4*)(bob + cb), c1 = *(const f32x4*)(bob + cb + 4);
#pragma unroll
      for (int e = 0; e < 4; ++e) { ba[e] = a0[e]; ba[4 + e] = a1[e]; bb[e] = b0[e]; bb[4 + e] = b1[e]; bo[e] = c0[e]; bo[4 + e] = c1[e]; } }
    for (size_t i0 = gt; i0 < (size_t)M * D / 8; i0 += 2 * (size_t)NT) {
        u32x4 a[2], b[2], c[2], d[2];
#pragma unroll
        for (int q = 0; q < 2; ++q) { const size_t i = i0 + (size_t)q * NT; a[q] = *(const u32x4*)(MA + i * 8); b[q] = *(const u32x4*)(MB + i * 8); c[q] = *(const u32x4*)(YA + i * 8); d[q] = *(const u32x4*)(YB + i * 8); }
#pragma unroll
        for (int q = 0; q < 2; ++q) { const size_t i = i0 + (size_t)q * NT;
            float ma[8], mb[8], ya[8], yb[8], r[8];
            unpack8(a[q], ma); unpack8(b[q], mb); unpack8(c[q], ya); unpack8(d[q], yb);
#pragma unroll
            for (int e = 0; e < 8; ++e) r[e] = sigm(ma[e] + ba[e]) * ya[e] + sigm(mb[e] + bb[e]) * (yb[e] + bo[e]);
            *(u32x4*)(MG + i * 8) = pack8(r); }
    }
}

__device__ __forceinline__ void p7_phase(float* out, const bf16_t* Y2, const float* x, const float* mod, const float* fgain, int G) {
    const int lane = threadIdx.x & 63, gw = blockIdx.x * 8 + (threadIdx.x >> 6), NGW = G * 8;
    f32x4 g[4];
#pragma unroll
    for (int j = 0; j < 4; ++j) g[j] = *(const f32x4*)(fgain + 4 * lane + 256 * j);
    for (int row0 = gw; row0 < M; row0 += 2 * NGW) {
        f32x4 v[2][4]; u32x2 y[2][4]; float ss[2];
#pragma unroll
        for (int q = 0; q < 2; ++q) { const size_t ro = (size_t)(row0 + q * NGW) * D; const f32x4* xr = (const f32x4*)(x + ro) + lane; const u32x2* yr = (const u32x2*)(Y2 + ro) + lane;
#pragma unroll
            for (int j = 0; j < 4; ++j) { v[q][j] = xr[64 * j]; y[q][j] = yr[64 * j]; } }
#pragma unroll
        for (int q = 0; q < 2; ++q) { const int row = row0 + q * NGW; const f32x4* gt = (const f32x4*)(mod + (size_t)(row >> 12) * 3 * D + 2 * D) + lane; ss[q] = 0.f;
#pragma unroll
            for (int j = 0; j < 4; ++j) { const f32x4 yy = (f32x4){bflo(y[q][j].x), bfhi(y[q][j].x), bflo(y[q][j].y), bfhi(y[q][j].y)};
                v[q][j] = v[q][j] + gt[64 * j] * yy; ss[q] += (v[q][j].x * v[q][j].x + v[q][j].y * v[q][j].y) + (v[q][j].z * v[q][j].z + v[q][j].w * v[q][j].w); } }
#pragma unroll
        for (int q = 0; q < 2; ++q) { f32x4* orow = (f32x4*)(out + (size_t)(row0 + q * NGW) * D) + lane;
            const float r = rsqrtf(wave_sum(ss[q]) * (1.f / D) + EPS);
#pragma unroll
            for (int j = 0; j < 4; ++j) orow[64 * j] = (v[q][j] * r) * g[j]; }
    }
}

#define XB_TMO      128
#define XB_XCNT(j)  (256  + 64 * (j))
#define XB_XSUB(j)  (1280 + 64 * (j))
#define XB_XGEN(j)  (2304 + 64 * (j))
#define XB_TOP      3328
#define XB_TOPGEN   3392
#define XCD_BAR_WORDS 3456
#define XB_SPIN_CAP (1u << 18)
__device__ __forceinline__ unsigned xb_ld(unsigned* p)              { return __hip_atomic_load(p, __ATOMIC_RELAXED, __HIP_MEMORY_SCOPE_AGENT); }
__device__ __forceinline__ unsigned xb_add(unsigned* p, unsigned v) { return __hip_atomic_fetch_add(p, v, __ATOMIC_RELAXED, __HIP_MEMORY_SCOPE_AGENT); }
__device__ __forceinline__ unsigned xb_xcc_id() { return (unsigned)__builtin_amdgcn_s_getreg((3 << 11) | 20) & 0xFu; }
#define XB_SPIN(cond, bar) do { unsigned _sp = 0; while (cond) { __builtin_amdgcn_s_sleep(1); \
    if ((++_sp & 255u) == 0u) { if (xb_ld(&(bar)[XB_TMO])) break; if (_sp > XB_SPIN_CAP) { atomicAdd(&(bar)[XB_TMO], 1u); break; } } } } while (0)
struct XcdBarrier { unsigned* bar; unsigned x; volatile LAS unsigned* st; };
__device__ __forceinline__ XcdBarrier xcd_barrier_post(unsigned* bar, volatile LAS unsigned* st) {
    XcdBarrier b; b.bar = bar; b.x = xb_xcc_id(); b.st = st;
    if (threadIdx.x == 0) (void)xb_add(&bar[XB_XCNT(b.x)], 1u);
    return b;
}
__device__ __forceinline__ void xcd_barrier_complete(unsigned* bar, unsigned x, unsigned& nloc, unsigned& nx) {
    const unsigned G = gridDim.x * gridDim.y * gridDim.z;
    unsigned sum, cnt, mine, sp = 0u;
    for (;;) {
        sum = 0u; cnt = 0u; mine = 0u;
#pragma unroll
        for (unsigned j = 0; j < 16; ++j) { const unsigned c = xb_ld(&bar[XB_XCNT(j)]); sum += c; cnt += (c > 0u) ? 1u : 0u; mine = (j == x) ? c : mine; }
        if (sum == G) break;
        __builtin_amdgcn_s_sleep(1);
        if ((++sp & 255u) == 0u) { if (xb_ld(&bar[XB_TMO])) break; if (sp > XB_SPIN_CAP) { atomicAdd(&bar[XB_TMO], 1u); break; } }
    }
    nloc = mine > 0u ? mine : 1u; nx = cnt > 0u ? cnt : 1u;
}
__device__ __forceinline__ void xcd_barrier(const XcdBarrier& b) {
    asm volatile("s_waitcnt vmcnt(0)" ::: "memory");
    __syncthreads();
    if (threadIdx.x == 0) {
        unsigned* bar = b.bar;
        __builtin_amdgcn_s_waitcnt(0);
        unsigned nloc = b.st[0], nx = b.st[1];
        if (nloc == 0u) { xcd_barrier_complete(bar, b.x, nloc, nx); b.st[0] = nloc; b.st[1] = nx; }
        const unsigned old = xb_add(&bar[XB_XSUB(b.x)], 1u);
        const unsigned gen = old / nloc;
        if (old + 1u == (gen + 1u) * nloc) {
            __builtin_amdgcn_fence(__ATOMIC_RELEASE, "agent");
            asm volatile("s_waitcnt vmcnt(0)" ::: "memory");
            const unsigned og = xb_add(&bar[XB_TOP], 1u);
            const unsigned tg = og / nx;
            if (og + 1u == (tg + 1u) * nx) xb_add(&bar[XB_TOPGEN], 1u);
            else XB_SPIN(xb_ld(&bar[XB_TOPGEN]) == tg, bar);
            __builtin_amdgcn_fence(__ATOMIC_ACQUIRE, "agent");
            xb_add(&bar[XB_XGEN(b.x)], 1u);
            asm volatile("s_waitcnt vmcnt(0)" ::: "memory");
        } else {
            XB_SPIN(xb_ld(&bar[XB_XGEN(b.x)]) == gen, bar);
            __builtin_amdgcn_fence(__ATOMIC_ACQUIRE, "agent");
            asm volatile("s_waitcnt vmcnt(0)" ::: "memory");
        }
    }
    __syncthreads();
}

struct Args { const float* in[17]; float* out; unsigned char* ws; int ph_lo, ph_hi; };

__global__ void __launch_bounds__(512, 2) fwd_kernel(Args a) {
    extern __shared__ __attribute__((aligned(16))) unsigned char shm[];
    LAS unsigned char* lds = (LAS unsigned char*)shm;
    cg::grid_group grid = cg::this_grid();
    const int G = gridDim.x, lo = a.ph_lo, hi = a.ph_hi;
    unsigned char* ws = a.ws;
    bf16_t* act = (bf16_t*)(ws + WS_ACT);
    const float* mod = (const float*)(ws + WS_MOD);
#define IN(k) (lo <= (k) && (k) < hi)
#define SEAM(k) do { if (IN(k) && IN((k) + 1)) { if ((k) == 0) grid.sync(); else xcd_barrier(xbar); } } while (0)
    volatile LAS unsigned* xst = (volatile LAS unsigned*)(lds + 131072);
    if (threadIdx.x < 4) xst[threadIdx.x] = 0u;
    __syncthreads();
    XcdBarrier xbar; xbar.bar = (unsigned*)(ws + WS_BAR); xbar.x = 0; xbar.st = xst;
    if (hi - lo > 1) xbar = xcd_barrier_post((unsigned*)(ws + WS_BAR), xst);
    if (IN(0)) p0_phase(lds, a.in[1], a.in[3], a.in[4], a.in[5], a.in[8], a.in[13], a.in[15], ws, G);
    SEAM(0);
    if (IN(1)) p1_phase(a.in[0], a.in[2], mod, act, G);
    SEAM(1);
    if (IN(2)) { pg8::Gemm g{act, (const bf16_t*)(ws + WS_W1T), M, DIN, D}; pg8::StaticOrder S; S.init(M, DIN, G, (int)blockIdx.x);
        Epi1 E{act}; pg8::gemm_phase<Epi1, pg8::StaticOrder, true, true>(lds, g, S, E); }
    SEAM(2);
    if (IN(3)) { p3a_phase(act + 1 * (SLOT / 2), act + 2 * (SLOT / 2), a.in[7], G);
        p3b_phase(lds, act + 3 * (SLOT / 2), act + 4 * (SLOT / 2), a.in[9], a.in[10], a.in[11], a.in[12], G); }
    SEAM(3);
    if (IN(4)) { pg8::Gemm g{act + 2 * (SLOT / 2), (const bf16_t*)(ws + WS_WAB), M, D, D}; pg8::PairOrder S; S.init(M, D, G, (int)blockIdx.x);
        EpiY E{act}; pg8::gemm_phase<EpiY, pg8::PairOrder, true, true>(lds, g, S, E); }
    SEAM(4);
    if (IN(5)) merge_phase(act + 5 * (SLOT / 2), act + 6 * (SLOT / 2), act, act + 1 * (SLOT / 2), act + 4 * (SLOT / 2), a.in[6], a.in[14], G);
    SEAM(5);
    if (IN(6)) { pg8::Gemm g{act + 4 * (SLOT / 2), (const bf16_t*)(ws + WS_WOT), M, D, D}; pg8::StaticOrder S; S.init(M, D, G, (int)blockIdx.x);
        EpiY E{act}; pg8::gemm_phase<EpiY, pg8::StaticOrder, true, true>(lds, g, S, E); }
    SEAM(6);
    if (IN(7)) p7_phase(a.out, act, a.in[0], mod, a.in[16], G);
#undef IN
#undef SEAM
}

extern "C" void kernel_launch(void* const* d_in, const int* in_sizes, int n_in, void* d_out, int out_size, void* d_ws, size_t ws_size, hipStream_t stream) {
    static int grid = 0;
    if (grid == 0) {
        if (n_in != 17 || out_size != M * D || ws_size < WS_END) { fprintf(stderr, "kernel_launch: unexpected shapes (n_in %d out %d ws %zu, need %zu)\n", n_in, out_size, ws_size, (size_t)WS_END); grid = -1; return; }
        int dev = 0, cus = 0, per_cu = 0;
        (void)hipGetDevice(&dev); (void)hipDeviceGetAttribute(&cus, hipDeviceAttributeMultiprocessorCount, dev);
        if (hipFuncSetAttribute((const void*)fwd_kernel, hipFuncAttributeMaxDynamicSharedMemorySize, LDS_BYTES) != hipSuccess) { fprintf(stderr, "kernel_launch: hipFuncSetAttribute failed\n"); grid = -1; return; }
        if (hipOccupancyMaxActiveBlocksPerMultiprocessor(&per_cu, (const void*)fwd_kernel, 512, LDS_BYTES) != hipSuccess || per_cu < 1) { fprintf(stderr, "kernel_launch: occupancy query says %d\n", per_cu); per_cu = 1; }
        (void)hipGetLastError();
        grid = cus;
    }
    if (grid < 0) return;
    Args a{};
    for (int i = 0; i < 17; ++i) a.in[i] = (const float*)d_in[i];
    a.out = (float*)d_out; a.ws = (unsigned char*)d_ws;
#if N_LAUNCHES == 1
    (void)hipMemsetAsync((char*)d_ws + WS_BAR, 0, XCD_BAR_WORDS * 4, stream);
    a.ph_lo = 0; a.ph_hi = 8;
    void* args[] = {&a};
    hipError_t e = hipLaunchCooperativeKernel((const void*)fwd_kernel, dim3(grid), dim3(512), args, LDS_BYTES, stream);
    if (e != hipSuccess) fprintf(stderr, "cooperative launch failed: %s (grid %d)\n", hipGetErrorString(e), grid);
#else
    for (int ph = 0; ph < 8; ++ph) { a.ph_lo = ph; a.ph_hi = ph + 1; hipLaunchKernelGGL(fwd_kernel, dim3(grid), dim3(512), LDS_BYTES, stream, a); }
#endif
}
```

```cpp
#include <hip/hip_runtime.h>
#include <hip/hip_cooperative_groups.h>
#include <cstdio>
namespace cg = cooperative_groups;

#ifndef N_LAUNCHES
#define N_LAUNCHES 1
#endif

#define LAS __attribute__((address_space(3)))
typedef unsigned short bf16_t;
typedef short bf16x8 __attribute__((ext_vector_type(8)));
typedef float f32x4 __attribute__((ext_vector_type(4)));
typedef unsigned u32x4 __attribute__((ext_vector_type(4)));
typedef unsigned u32x2 __attribute__((ext_vector_type(2)));

constexpr int D = 1024, NBATCH = 8, SEQ = 4096, M = NBATCH * SEQ, DIN = 9216;
constexpr float EPS = 1e-6f;
constexpr int LDS_BYTES = 131072 + 16;

constexpr size_t WS_W1T = 0;
constexpr size_t WS_WAB = WS_W1T + (size_t)DIN * D * 2;
constexpr size_t WS_WOT = WS_WAB + (size_t)2 * D * D * 2;
constexpr size_t WS_MOD = WS_WOT + (size_t)D * D * 2;
constexpr size_t WS_BAR = WS_MOD + 98304;
constexpr size_t WS_ACT = WS_MOD + 131072;
constexpr size_t SLOT = (size_t)M * D * 2;
constexpr size_t WS_END = WS_ACT + 7 * SLOT;

__device__ __forceinline__ float bflo(unsigned u) { return __uint_as_float(u << 16); }
__device__ __forceinline__ float bfhi(unsigned u) { return __uint_as_float(u & 0xffff0000u); }
__device__ __forceinline__ unsigned cvt_pk_bf16(float lo, float hi) { unsigned r; asm("v_cvt_pk_bf16_f32 %0, %1, %2" : "=v"(r) : "v"(lo), "v"(hi)); return r; }
__device__ __forceinline__ float sigm(float x) { return __builtin_amdgcn_rcpf(1.0f + __builtin_amdgcn_exp2f(-1.44269504f * x)); }
__device__ __forceinline__ float silu(float x) { return x * sigm(x); }
__device__ __forceinline__ void unpack8(const u32x4 v, float (&f)[8]) {
    f[0] = bflo(v.x); f[1] = bfhi(v.x); f[2] = bflo(v.y); f[3] = bfhi(v.y); f[4] = bflo(v.z); f[5] = bfhi(v.z); f[6] = bflo(v.w); f[7] = bfhi(v.w);
}
__device__ __forceinline__ u32x4 pack8(const float (&f)[8]) {
    u32x4 o; o.x = cvt_pk_bf16(f[0], f[1]); o.y = cvt_pk_bf16(f[2], f[3]); o.z = cvt_pk_bf16(f[4], f[5]); o.w = cvt_pk_bf16(f[6], f[7]); return o;
}
__device__ __forceinline__ float wave_sum(float v) {
#pragma unroll
    for (int o = 1; o < 64; o <<= 1) v += __shfl_xor(v, o);
    return v;
}
__device__ __forceinline__ float half_sum(float v) {
#pragma unroll
    for (int o = 1; o < 32; o <<= 1) v += __shfl_xor(v, o);
    return v;
}

namespace pg8 {
constexpr int BM = 256, BK = 64, HALF = 128, HTB = HALF * BK * 2, STAGE_BYTES = 8 * HTB, NXCD = 8, WGM = 8;
__host__ __device__ __forceinline__ int lds_byte(int r, int c) { const int st = (r >> 4) * 2 + (c >> 5), rr = r & 15, cc = c & 31, ob = rr * 64 + cc * 2; return st * 1024 + (ob ^ (((ob >> 9) & 1) << 5)); }
__host__ __device__ __forceinline__ void stage_rc(int b, int& R, int& C) { const int st = b / 1024, sb = b % 1024, swz = sb ^ (((sb >> 9) & 1) << 5); R = (st >> 1) * 16 + swz / 64; C = (st & 1) * 32 + (swz % 64) / 2; }
__host__ __device__ __forceinline__ int perm32(int rho) { const int n = rho >> 4, i = rho & 15; return 8 * (i >> 2) + 4 * n + (i & 3); }

struct Unit { int pm, pn; };
struct Gemm { const bf16_t* A; const bf16_t* Bt; int M, N, K; };

struct StaticOrder {
    int nM, nN, nwg, G, c;
    __device__ void init(int M_, int N_, int G_, int c_) { nM = M_ / BM; nN = N_ / BM; nwg = nM * nN; G = G_; c = c_; }
    __device__ bool map(long L, Unit& u) const {
        if (L >= nwg) return false;
        int wgid = (int)L; { const int q = nwg / NXCD, r = nwg % NXCD, xcd = wgid % NXCD, off = wgid / NXCD; wgid = (xcd < r ? xcd * (q + 1) : r * (q + 1) + (xcd - r) * q) + off; }
        const int nig = WGM * nN, gid = wgid / nig, fm = gid * WGM, gsz = (nM - fm) < WGM ? (nM - fm) : WGM;
        u.pm = fm + ((wgid % nig) % gsz); u.pn = (wgid % nig) / gsz; return true;
    }
    __device__ bool next(int i, Unit& u) const { return map((long)i * G + c, u); }
    __device__ __forceinline__ void a_ready(const Unit&) const {}
    __device__ __forceinline__ void done(const Unit&) const {}
};
struct PairOrder : StaticOrder {
    __device__ bool next(int i, Unit& u) const {
        const int j = i >> 1, h = i & 1;
        if (!map((long)j * G + c, u)) return false;
        u.pm += h * nM; u.pn += h * nN; return true;
    }
};

template <class Epi, class Sched, bool ALIGN_EPI = false, bool SP2 = false>
__device__ __forceinline__ void gemm_phase(LAS unsigned char* lds, const Gemm g, const Sched& S, const Epi& E) {
    const int tid = threadIdx.x, wid = __builtin_amdgcn_readfirstlane(tid >> 6), lane = tid & 63, wr = wid >> 2, wc = wid & 3, fr = lane & 15, fq = lane >> 4;
    const int K = g.K, nt = K / BK;
    unsigned voffA[2], voffB[2];
#pragma unroll
    for (int i = 0; i < 2; ++i) { int R, C; stage_rc(tid * 16 + i * 8192, R, C); const int Rb = Epi::PERM ? ((R & ~31) + perm32(R & 31)) : R;
        voffA[i] = (unsigned)(R * K + C) * 2u; voffB[i] = (unsigned)(Rb * K + C) * 2u; }
    const size_t kstep = (size_t)(BK * 2);
    const size_t hstep = (size_t)HALF * K * 2;
    const size_t tstep = 2 * hstep;
    const unsigned ldsw = (unsigned)wid * 1024u;
    const int aoff = lds_byte(wr * 64 + fr, fq * 8), boff = lds_byte(wc * 32 + fr, fq * 8);
#define PG8_SA(b, h) (((b) * 2 + (h)) * HTB)
#define PG8_SB(b, h) ((4 + (b) * 2 + (h)) * HTB)
#define PG8_STAGE(bufoff, gbase, voff) do { _Pragma("unroll") for (int _i = 0; _i < 2; ++_i) \
        __builtin_amdgcn_global_load_lds((const unsigned*)((const char*)(gbase) + (voff)[_i]), (LAS unsigned*)(lds + (bufoff) + ldsw + _i * 8192), 16, 0, 0); } while (0)
#define PG8_LDA(dst, b, h) do { _Pragma("unroll") for (int m = 0; m < 4; ++m) _Pragma("unroll") for (int k = 0; k < 2; ++k) dst[m][k] = *(const LAS bf16x8*)(lds + PG8_SA(b, h) + aoff + m * 2048 + k * 1024); } while (0)
#define PG8_LDB(dst, b, h) do { _Pragma("unroll") for (int n = 0; n < 2; ++n) _Pragma("unroll") for (int k = 0; k < 2; ++k) dst[n][k] = *(const LAS bf16x8*)(lds + PG8_SB(b, h) + boff + n * 2048 + k * 1024); } while (0)
#define PG8_MMA(ai, bj, At, Bt) do { __builtin_amdgcn_s_setprio(1); _Pragma("unroll") for (int m = 0; m < 4; ++m) _Pragma("unroll") for (int n = 0; n < 2; ++n) _Pragma("unroll") for (int k = 0; k < 2; ++k) \
        acc[ai][bj][m][n] = __builtin_amdgcn_mfma_f32_16x16x32_bf16(Bt[n][k], At[m][k], acc[ai][bj][m][n], 0, 0, 0); __builtin_amdgcn_s_setprio(0); } while (0)
#define PG8_WAIT_V(n) asm volatile("s_waitcnt vmcnt(" #n ")" ::: "memory")
#define PG8_WAIT_L(n) asm volatile("s_waitcnt lgkmcnt(" #n ")" ::: "memory")
#define PG8_BAR __builtin_amdgcn_s_barrier()
#define PG8_SCHED __builtin_amdgcn_sched_barrier(0)
    Unit cur, nxt; int ui = 0;
    if (!S.next(0, cur)) return;
    f32x4 acc[2][2][4][2];
#pragma unroll
    for (int a = 0; a < 2; ++a)
#pragma unroll
        for (int b = 0; b < 2; ++b)
#pragma unroll
            for (int m = 0; m < 4; ++m)
#pragma unroll
                for (int n = 0; n < 2; ++n) acc[a][b][m][n] = (f32x4){0.f, 0.f, 0.f, 0.f};
    bf16x8 At[4][2], B0[2][2], B1[2][2];
    const char* cA = (const char*)g.A + (size_t)cur.pm * tstep; const char* cB = (const char*)g.Bt + (size_t)cur.pn * tstep;
    S.a_ready(cur);
    if constexpr (SP2) {
        PG8_STAGE(PG8_SB(0, 0), cB, voffB); PG8_STAGE(PG8_SB(0, 1), cB + hstep, voffB); PG8_STAGE(PG8_SA(0, 0), cA, voffA); PG8_STAGE(PG8_SA(0, 1), cA + hstep, voffA);
        if (wr == 1) PG8_BAR;
        PG8_WAIT_V(2); PG8_BAR;
        PG8_STAGE(PG8_SB(1, 0), cB + kstep, voffB); PG8_STAGE(PG8_SA(1, 0), cA + kstep, voffA); PG8_STAGE(PG8_SB(1, 1), cB + hstep + kstep, voffB);
        PG8_WAIT_V(6); PG8_BAR;
    } else {
        PG8_STAGE(PG8_SB(0, 0), cB, voffB); PG8_STAGE(PG8_SA(0, 0), cA, voffA); PG8_STAGE(PG8_SB(0, 1), cB + hstep, voffB); PG8_STAGE(PG8_SA(0, 1), cA + hstep, voffA);
        if (wr == 1) PG8_BAR;
        PG8_WAIT_V(4); PG8_BAR;
        PG8_STAGE(PG8_SB(1, 0), cB + kstep, voffB); PG8_STAGE(PG8_SA(1, 0), cA + kstep, voffA); PG8_STAGE(PG8_SB(1, 1), cB + hstep + kstep, voffB);
        PG8_WAIT_V(6); PG8_BAR;
    }
    for (;;) {
        const bool has_next = S.next(ui + 1, nxt);
        const char* nA = has_next ? (const char*)g.A + (size_t)nxt.pm * tstep : cA; const char* nB = has_next ? (const char*)g.Bt + (size_t)nxt.pn * tstep : cB;
        for (int t = 0; t < nt; t += 2) {
            const bool last = (t == nt - 2);
            const char* a1 = cA + (size_t)(t + 1) * kstep;
            const char* a2 = last ? nA : cA + (size_t)(t + 2) * kstep; const char* b2 = last ? nB : cB + (size_t)(t + 2) * kstep;
            const char* a3 = a2 + kstep; const char* b3 = b2 + kstep;
            if (last && has_next) S.a_ready(nxt);
            if constexpr (SP2) {
            PG8_LDB(B0, 0, 0); PG8_LDB(B1, 0, 1); PG8_SCHED; PG8_LDA(At, 0, 0); PG8_STAGE(PG8_SA(1, 1), a1 + hstep, voffA);
            PG8_WAIT_V(8); PG8_WAIT_L(0); PG8_BAR; PG8_MMA(0, 0, At, B0); PG8_MMA(0, 1, At, B1); PG8_BAR; PG8_SCHED;
            PG8_LDA(At, 0, 1); PG8_STAGE(PG8_SB(0, 0), b2, voffB); PG8_STAGE(PG8_SB(0, 1), b2 + hstep, voffB); PG8_STAGE(PG8_SA(0, 0), a2, voffA);
            PG8_WAIT_V(8); PG8_WAIT_L(0); PG8_BAR; PG8_MMA(1, 0, At, B0); PG8_MMA(1, 1, At, B1); PG8_BAR; PG8_SCHED;
            PG8_LDB(B0, 1, 0); PG8_LDB(B1, 1, 1); PG8_SCHED; PG8_LDA(At, 1, 0); PG8_STAGE(PG8_SA(0, 1), a2 + hstep, voffA);
            PG8_WAIT_V(8); PG8_WAIT_L(0); PG8_BAR; PG8_MMA(0, 0, At, B0); PG8_MMA(0, 1, At, B1); PG8_BAR; PG8_SCHED;
            PG8_LDA(At, 1, 1); PG8_STAGE(PG8_SB(1, 0), b3, voffB); PG8_STAGE(PG8_SB(1, 1), b3 + hstep, voffB); PG8_STAGE(PG8_SA(1, 0), a3, voffA);
            PG8_WAIT_V(8); PG8_WAIT_L(0); PG8_BAR; PG8_MMA(1, 0, At, B0); PG8_MMA(1, 1, At, B1); PG8_BAR; PG8_SCHED;
            } else {
            PG8_LDB(B0, 0, 0); PG8_SCHED; PG8_LDA(At, 0, 0); PG8_STAGE(PG8_SA(1, 1), a1 + hstep, voffA);
            PG8_WAIT_L(8); PG8_BAR; PG8_WAIT_L(0); PG8_MMA(0, 0, At, B0); PG8_BAR; PG8_SCHED;
            PG8_LDB(B1, 0, 1); PG8_STAGE(PG8_SB(0, 0), b2, voffB);
            PG8_BAR; PG8_WAIT_L(0); PG8_MMA(0, 1, At, B1); PG8_BAR;
            PG8_LDA(At, 0, 1); PG8_STAGE(PG8_SA(0, 0), a2, voffA);
            PG8_BAR; PG8_WAIT_L(0); PG8_MMA(1, 0, At, B0); PG8_BAR; PG8_SCHED;
            PG8_STAGE(PG8_SB(0, 1), b2 + hstep, voffB);
            PG8_WAIT_V(6); PG8_BAR; PG8_MMA(1, 1, At, B1); PG8_BAR;
            PG8_LDB(B0, 1, 0); PG8_SCHED; PG8_LDA(At, 1, 0); PG8_STAGE(PG8_SA(0, 1), a2 + hstep, voffA);
            PG8_WAIT_L(8); PG8_BAR; PG8_WAIT_L(0); PG8_MMA(0, 0, At, B0); PG8_BAR; PG8_SCHED;
            PG8_LDB(B1, 1, 1); PG8_STAGE(PG8_SB(1, 0), b3, voffB);
            PG8_BAR; PG8_WAIT_L(0); PG8_MMA(0, 1, At, B1); PG8_BAR;
            PG8_LDA(At, 1, 1); PG8_STAGE(PG8_SA(1, 0), a3, voffA);
            PG8_BAR; PG8_WAIT_L(0); PG8_MMA(1, 0, At, B0); PG8_BAR; PG8_SCHED;
            PG8_STAGE(PG8_SB(1, 1), b3 + hstep, voffB);
            PG8_WAIT_V(6); PG8_BAR; PG8_MMA(1, 1, At, B1); PG8_BAR;
            }
        }
        if constexpr (ALIGN_EPI) { if (wr == 0) PG8_BAR; }
        E(acc, cur, wr, wc, fr, fq); S.done(cur);
        if (!has_next) break;
#pragma unroll
        for (int a = 0; a < 2; ++a)
#pragma unroll
            for (int b = 0; b < 2; ++b)
#pragma unroll
                for (int m = 0; m < 4; ++m)
#pragma unroll
                    for (int n = 0; n < 2; ++n) acc[a][b][m][n] = (f32x4){0.f, 0.f, 0.f, 0.f};
        cur = nxt; cA = nA; cB = nB; ++ui;
        if constexpr (ALIGN_EPI) { if (wr == 1) PG8_BAR; }
    }
    PG8_WAIT_V(0);
    if constexpr (!ALIGN_EPI) { if (wr == 0) PG8_BAR; }
    PG8_BAR;
#undef PG8_SA
#undef PG8_SB
#undef PG8_STAGE
#undef PG8_LDA
#undef PG8_LDB
#undef PG8_MMA
#undef PG8_WAIT_V
#undef PG8_WAIT_L
#undef PG8_BAR
#undef PG8_SCHED
}
}


struct Epi1 {
    static constexpr bool PERM = true;
    bf16_t* act;
    template <int MODE> __device__ __forceinline__ void pair(const f32x4 (&acc)[2][2][4][2], bf16_t* O, int row0, int col0) const {
#pragma unroll
        for (int ai = 0; ai < 2; ++ai)
#pragma unroll
            for (int m = 0; m < 4; ++m) {
                float r[8];
#pragma unroll
                for (int n = 0; n < 2; ++n)
#pragma unroll
                    for (int j = 0; j < 4; ++j) { const float a = acc[ai][0][m][n][j], b = acc[ai][1][m][n][j];
                        r[4 * n + j] = MODE == 0 ? a * b : (MODE == 1 ? a * silu(b) : a * sigm(b)); }
                *(u32x4*)(O + (size_t)(row0 + ai * 128 + m * 16) * D + col0) = pack8(r);
            }
    }
    template <int MODE> __device__ __forceinline__ void single(const f32x4 (&acc)[2][2][4][2], bf16_t* O, int row0, int col0) const {
#pragma unroll
        for (int bj = 0; bj < 2; ++bj)
#pragma unroll
            for (int ai = 0; ai < 2; ++ai)
#pragma unroll
                for (int m = 0; m < 4; ++m) {
                    float r[8];
#pragma unroll
                    for (int j = 0; j < 4; ++j) { const float v0 = acc[ai][bj][m][0][j], v1 = acc[ai][bj][m][1][j];
                        r[j] = MODE == 0 ? silu(v0) : v0; r[4 + j] = MODE == 0 ? silu(v1) : v1; }
                    *(u32x4*)(O + (size_t)(row0 + ai * 128 + m * 16) * D + col0 + bj * 128) = pack8(r);
                }
    }
    __device__ __forceinline__ void operator()(const f32x4 (&acc)[2][2][4][2], const pg8::Unit& u, int wr, int wc, int fr, int fq) const {
        const int row0 = u.pm * 256 + wr * 64 + fr, tile = u.pn;
        if (tile < 24) {
            const int grp = tile >> 3, col0 = 128 * (tile & 7) + wc * 32 + 8 * fq;
            if (grp == 0) pair<0>(acc, act + 1 * (SLOT / 2), row0, col0);
            else if (grp == 1) pair<1>(acc, act + 2 * (SLOT / 2), row0, col0);
            else pair<2>(acc, act + 4 * (SLOT / 2), row0, col0);
        } else {
            const int t2 = tile - 24, g2 = t2 >> 2, col0 = 256 * (t2 & 3) + wc * 32 + 8 * fq;
            if (g2 == 0) single<0>(acc, act + 3 * (SLOT / 2), row0, col0);
            else single<1>(acc, act + (4 + g2) * (SLOT / 2), row0, col0);
        }
    }
};

struct EpiY {
    static constexpr bool PERM = true;
    bf16_t* Y;
    __device__ __forceinline__ void operator()(const f32x4 (&acc)[2][2][4][2], const pg8::Unit& u, int wr, int wc, int fr, int fq) const {
        const int row0 = u.pm * 256 + wr * 64 + fr, col0 = (u.pn & 3) * 256 + wc * 32 + 8 * fq;
#pragma unroll
        for (int bj = 0; bj < 2; ++bj)
#pragma unroll
            for (int ai = 0; ai < 2; ++ai)
#pragma unroll
                for (int m = 0; m < 4; ++m) {
                    float r[8];
#pragma unroll
                    for (int j = 0; j < 4; ++j) { r[j] = acc[ai][bj][m][0][j]; r[4 + j] = acc[ai][bj][m][1][j]; }
                    *(u32x4*)(Y + (size_t)(row0 + ai * 128 + m * 16) * D + col0 + bj * 128) = pack8(r);
                }
    }
};
__device__ __forceinline__ int w1_srccol(int nc) {
    const int tile = nc >> 8, within = nc & 255;
    if (tile < 24) { const int grp = tile >> 3, half = within >> 7, ch = 128 * (tile & 7) + (within & 127);
        const int split = grp == 0 ? (half ? 2 : 1) : (grp == 1 ? (half ? 3 : 0) : (half ? 5 : 4));
        return split * 1024 + ch; }
    const int t2 = tile - 24;
    return (6 + (t2 >> 2)) * 1024 + 256 * (t2 & 3) + within;
}
__device__ __forceinline__ void transpose_item(const float* W, int ldw, int srccol0, bf16_t* WT, int row0, int k0, LAS float* scr, int lane) {
#pragma unroll 8
    for (int i = 0; i < 32; ++i) { const int kk = 2 * i + (lane >> 5); scr[kk * 33 + (lane & 31)] = W[(size_t)(k0 + kk) * ldw + srccol0 + (lane & 31)]; }
    asm volatile("s_waitcnt lgkmcnt(0)" ::: "memory");
    const int c = lane & 7;
#pragma unroll
    for (int j = 0; j < 4; ++j) { const int n = (lane >> 3) + 8 * j; const LAS float* s = scr + (8 * c) * 33 + n;
        u32x4 o; o.x = cvt_pk_bf16(s[0 * 33], s[1 * 33]); o.y = cvt_pk_bf16(s[2 * 33], s[3 * 33]); o.z = cvt_pk_bf16(s[4 * 33], s[5 * 33]); o.w = cvt_pk_bf16(s[6 * 33], s[7 * 33]);
        *(u32x4*)(WT + (size_t)(row0 + n) * D + k0 + 8 * c) = o; }
    asm volatile("s_waitcnt lgkmcnt(0)" ::: "memory");
}
__device__ __forceinline__ void p0_phase(LAS unsigned char* lds, const float* c, const float* w_ada, const float* b_ada, unsigned char* ws, int G) {
    const int tid = threadIdx.x, lane = tid & 63, wave = tid >> 6;
    float* mod = (float*)(ws + WS_MOD);
    for (int item = blockIdx.x; item < 192; item += G) {
        LAS float* cact = (LAS float*)lds;
        LAS float* red = (LAS float*)(lds + 32768);
        for (int i = tid; i < NBATCH * D; i += 512) cact[i] = silu(c[i]);
        __syncthreads();
        const int col = tid & 15, kg = tid >> 4, j = item * 16 + col;
        float a[8];
#pragma unroll
        for (int b = 0; b < 8; ++b) a[b] = 0.f;
#pragma unroll 8
        for (int kk = 0; kk < 32; ++kk) { const int k = kg * 32 + kk; const float w = w_ada[(size_t)k * (3 * D) + j];
#pragma unroll
            for (int b = 0; b < 8; ++b) a[b] = fmaf(cact[b * D + k], w, a[b]); }
#pragma unroll
        for (int b = 0; b < 8; ++b) red[(b * 16 + col) * 33 + kg] = a[b];
        __syncthreads();
        if (tid < 128) { const int b = tid >> 4, cl = tid & 15; float s = 0.f;
            for (int q = 0; q < 32; ++q) s += red[(b * 16 + cl) * 33 + q];
            mod[b * 3 * D + item * 16 + cl] = s + b_ada[item * 16 + cl]; }
        __syncthreads();
    }
}
__device__ __forceinline__ void p0b_phase(LAS unsigned char* lds, const float* w_in, const float* w_out_a, const float* w_out_b, const float* w_o, unsigned char* ws, int G) {
    const int tid = threadIdx.x, lane = tid & 63, wave = tid >> 6;
    LAS float* scr = (LAS float*)(lds + wave * 8448);
    const int gw = blockIdx.x * 8 + wave, NGW = G * 8;
    bf16_t* W1T = (bf16_t*)(ws + WS_W1T); bf16_t* WAB = (bf16_t*)(ws + WS_WAB); bf16_t* WOT = (bf16_t*)(ws + WS_WOT);
    constexpr int I1 = 16 * (DIN / 32), I2 = 16 * (D / 32);
    for (int it = gw; it < I1 + 3 * I2; it += NGW) {
        int r = it;
        if (r < I1) { const int kb = r / (DIN / 32), nb = r % (DIN / 32); transpose_item(w_in, DIN, w1_srccol(nb * 32), W1T, nb * 32, kb * 64, scr, lane); continue; }
        r -= I1;
        const int which = r / I2; r -= which * I2;
        const int kb = r / (D / 32), nb = r % (D / 32);
        if (which == 0) transpose_item(w_out_a, D, nb * 32, WAB, nb * 32, kb * 64, scr, lane);
        else if (which == 1) transpose_item(w_out_b, D, nb * 32, WAB, D + nb * 32, kb * 64, scr, lane);
        else transpose_item(w_o, D, nb * 32, WOT, nb * 32, kb * 64, scr, lane);
    }
}

__device__ __forceinline__ void p1_phase(const float* x, const float* gain, const float* mod, bf16_t* H, int G) {
    const int lane = threadIdx.x & 63, gw = blockIdx.x * 8 + (threadIdx.x >> 6), NGW = G * 8;
    for (int row0 = gw; row0 < M; row0 += 2 * NGW) {
        f32x4 v[2][4]; float ss[2];
#pragma unroll
        for (int q = 0; q < 2; ++q) { const f32x4* xr = (const f32x4*)(x + (size_t)(row0 + q * NGW) * D) + lane; ss[q] = 0.f;
#pragma unroll
            for (int j = 0; j < 4; ++j) v[q][j] = xr[64 * j]; }
#pragma unroll
        for (int q = 0; q < 2; ++q) {
#pragma unroll
            for (int j = 0; j < 4; ++j) ss[q] += (v[q][j].x * v[q][j].x + v[q][j].y * v[q][j].y) + (v[q][j].z * v[q][j].z + v[q][j].w * v[q][j].w); }
#pragma unroll
        for (int q = 0; q < 2; ++q) { const int row = row0 + q * NGW;
            const float r = rsqrtf(wave_sum(ss[q]) * (1.f / D) + EPS);
            const float* shift = mod + (size_t)(row >> 12) * 3 * D; const float* scale = shift + D;
#pragma unroll
            for (int j = 0; j < 4; ++j) { const int cidx = 4 * lane + 256 * j;
                const f32x4 g = *(const f32x4*)(gain + cidx), sc = *(const f32x4*)(scale + cidx), sh = *(const f32x4*)(shift + cidx);
                const f32x4 h = (v[q][j] * r) * g * (1.0f + sc) + sh;
                u32x2 o; o.x = cvt_pk_bf16(h.x, h.y); o.y = cvt_pk_bf16(h.z, h.w);
                *(u32x2*)(H + (size_t)row * D + cidx) = o; } }
    }
}

__device__ __forceinline__ void p3a_phase(const bf16_t* CV, const bf16_t* BZ, bf16_t* AA, const float* wa, int G) {
    const int gt = blockIdx.x * 512 + threadIdx.x, NT = G * 512;
    for (int item = gt; item < (M / 4) * (D / 8); item += NT) {
        const int tq = item >> 7, cb = (item & 127) * 8, t0 = tq * 4, p0 = t0 & (SEQ - 1);
        float w0[8], w1[8], w2[8];
        { const f32x4 a = *(const f32x4*)(wa + cb), b = *(const f32x4*)(wa + cb + 4), c2 = *(const f32x4*)(wa + D + cb), d = *(const f32x4*)(wa + D + cb + 4),
              e2 = *(const f32x4*)(wa + 2 * D + cb), f = *(const f32x4*)(wa + 2 * D + cb + 4);
#pragma unroll
          for (int e = 0; e < 4; ++e) { w0[e] = a[e]; w0[4 + e] = b[e]; w1[e] = c2[e]; w1[4 + e] = d[e]; w2[e] = e2[e]; w2[4 + e] = f[e]; } }
        u32x4 rows[6], bzr[4];
#pragma unroll
        for (int i = 0; i < 6; ++i) { const int pos = p0 - 1 + i; rows[i] = (u32x4){0u, 0u, 0u, 0u};
            if (pos >= 0 && pos < SEQ) rows[i] = *(const u32x4*)(CV + (size_t)(t0 - 1 + i) * D + cb); }
#pragma unroll
        for (int j = 0; j < 4; ++j) bzr[j] = *(const u32x4*)(BZ + (size_t)(t0 + j) * D + cb);
#pragma unroll
        for (int j = 0; j < 4; ++j) { float a[8], b[8], c[8], bz[8], r[8];
            unpack8(rows[j], a); unpack8(rows[j + 1], b); unpack8(rows[j + 2], c); unpack8(bzr[j], bz);
#pragma unroll
            for (int e = 0; e < 8; ++e) r[e] = bz[e] * (w0[e] * a[e] + w1[e] * b[e] + w2[e] * c[e]);
            *(u32x4*)(AA + (size_t)(t0 + j) * D + cb) = pack8(r); }
    }
}
__device__ __forceinline__ void p3b_phase(LAS unsigned char* lds, const bf16_t* SZ, bf16_t* AB, const bf16_t* U, const float* wb, const float* cbias, const float* lng, const float* lnb, int G) {
    const int tid = threadIdx.x, co = tid & 31, tg = tid >> 5;
    LAS unsigned char* ut = lds;
    LAS unsigned char* wt = lds + 49152;
    for (int tile = blockIdx.x; tile < M / 64; tile += G) {
        const int t0 = tile * 64, p0 = t0 & (SEQ - 1);
        u32x4 pk[4][4];
        float s1[4], s2[4];
#pragma unroll
        for (int j = 0; j < 4; ++j) { s1[j] = 0.f; s2[j] = 0.f; }
#pragma unroll
        for (int ch = 0; ch < 4; ++ch) {
            __syncthreads();
            int c0 = ch * 256; asm volatile("" : "+s"(c0) :: "memory");
            const int cb = c0 + co * 8;
            {   const bf16_t* ug = U + (size_t)(t0 - 15 + tg) * D + c0 + co * 8; LAS unsigned char* ul = ut + tg * 512 + co * 16;
#pragma unroll
                for (int it = 0; it < 6; ++it) { const int r = it * 16 + tg, pos = p0 - 15 + r;
                    if (it < 5 || tg < 14) { u32x4 v = (u32x4){0u, 0u, 0u, 0u};
                        if (pos >= 0 && pos < SEQ) v = *(const u32x4*)(ug + (size_t)it * 16 * D);
                        *(LAS u32x4*)(ul + it * 8192) = v; } }
                const int wv = tid >> 6, cc = tid & 63;
                const float* wg = wb + (size_t)wv * D + c0 + cc * 4; LAS unsigned char* wl = wt + ((wv * 2 + (cc & 1)) * 32 + (cc >> 1)) * 16;
#pragma unroll
                for (int it = 0; it < 4; ++it) { if (it < 3 || wv < 7) *(LAS f32x4*)(wl + it * 8192) = *(const f32x4*)(wg + (size_t)it * 8 * D); } }
            __syncthreads();
            float acc[4][8];
            {   const f32x4 b0 = *(const f32x4*)(cbias + cb), b1 = *(const f32x4*)(cbias + cb + 4);
#pragma unroll
                for (int j = 0; j < 4; ++j)
#pragma unroll
                    for (int e = 0; e < 4; ++e) { acc[j][e] = b0[e]; acc[j][4 + e] = b1[e]; } }
            const LAS unsigned char* ub = ut + (tg * 4) * 512 + co * 16;
            const LAS unsigned char* wp = wt + co * 16;
#pragma unroll 1
            for (int k = 0; k < 30; k += 2) {
                float ur[5][8];
#pragma unroll
                for (int i = 0; i < 5; ++i) unpack8(*(const LAS u32x4*)(ub + (k + i) * 512), ur[i]);
                const f32x4 wa0 = *(const LAS f32x4*)(wp + k * 1024), wa1 = *(const LAS f32x4*)(wp + k * 1024 + 512);
                const f32x4 wb0 = *(const LAS f32x4*)(wp + k * 1024 + 1024), wb1 = *(const LAS f32x4*)(wp + k * 1024 + 1536);
#pragma unroll
                for (int j = 0; j < 4; ++j)
#pragma unroll
                    for (int e = 0; e < 4; ++e) {
                        acc[j][e] = fmaf(wb0[e], ur[j + 1][e], fmaf(wa0[e], ur[j][e], acc[j][e]));
                        acc[j][4 + e] = fmaf(wb1[e], ur[j + 1][4 + e], fmaf(wa1[e], ur[j][4 + e], acc[j][4 + e])); }
            }
            {   float ur[4][8];
#pragma unroll
                for (int i = 0; i < 4; ++i) unpack8(*(const LAS u32x4*)(ub + (30 + i) * 512), ur[i]);
                const f32x4 wa0 = *(const LAS f32x4*)(wp + 30 * 1024), wa1 = *(const LAS f32x4*)(wp + 30 * 1024 + 512);
#pragma unroll
                for (int j = 0; j < 4; ++j)
#pragma unroll
                    for (int e = 0; e < 4; ++e) { acc[j][e] = fmaf(wa0[e], ur[j][e], acc[j][e]); acc[j][4 + e] = fmaf(wa1[e], ur[j][4 + e], acc[j][4 + e]); }
            }
#pragma unroll
            for (int j = 0; j < 4; ++j) {
#pragma unroll
                for (int e = 0; e < 8; ++e) { s1[j] += acc[j][e]; s2[j] = fmaf(acc[j][e], acc[j][e], s2[j]); }
                pk[ch][j] = pack8(acc[j]); }
        }
        float mean[4], rstd[4];
#pragma unroll
        for (int j = 0; j < 4; ++j) { mean[j] = half_sum(s1[j]) * (1.f / D); const float ex2 = half_sum(s2[j]) * (1.f / D);
            rstd[j] = rsqrtf(fmaxf(ex2 - mean[j] * mean[j], 0.f) + EPS); }
#pragma unroll
        for (int ch = 0; ch < 4; ++ch) { int c0 = ch * 256; asm volatile("" : "+s"(c0) :: "memory"); const int cb = c0 + co * 8;
            float g[8], b[8];
            { const f32x4 g0 = *(const f32x4*)(lng + cb), g1 = *(const f32x4*)(lng + cb + 4), b0 = *(const f32x4*)(lnb + cb), b1 = *(const f32x4*)(lnb + cb + 4);
#pragma unroll
              for (int e = 0; e < 4; ++e) { g[e] = g0[e]; g[4 + e] = g1[e]; b[e] = b0[e]; b[4 + e] = b1[e]; } }
#pragma unroll
            for (int j = 0; j < 4; ++j) { const size_t off = (size_t)(t0 + tg * 4 + j) * D + cb;
                float sz[8], v[8], r[8]; unpack8(*(const u32x4*)(SZ + off), sz); unpack8(pk[ch][j], v);
#pragma unroll
                for (int e = 0; e < 8; ++e) { const float y = (v[e] - mean[j]) * rstd[j] * g[e] + b[e]; r[e] = silu(y) * sz[e]; }
                *(u32x4*)(AB + off) = pack8(r); } }
    }
}

__device__ __forceinline__ void merge_phase(const bf16_t* MA, const bf16_t* MB, const bf16_t* YA, const bf16_t* YB, bf16_t* MG, const float* bmerge, const float* bob, int G) {
    const int gt = blockIdx.x * 512 + threadIdx.x, NT = G * 512;
    const int cb = (gt & 127) * 8;
    float ba[8], bb[8], bo[8];
    { const f32x4 a0 = *(const f32x4*)(bmerge + cb), a1 = *(const f32x4*)(bmerge + cb + 4), b0 = *(const f32x4*)(bmerge + D + cb), b1 = *(const f32x4*)(bmerge + D + cb + 4),
          c0 = *(const f32x4*)(bob + cb), c1 = *(const f32x4*)(bob + cb + 4);
#pragma unroll
      for (int e = 0; e < 4; ++e) { ba[e] = a0[e]; ba[4 + e] = a1[e]; bb[e] = b0[e]; bb[4 + e] = b1[e]; bo[e] = c0[e]; bo[4 + e] = c1[e]; } }
    for (size_t i0 = gt; i0 < (size_t)M * D / 8; i0 += 2 * (size_t)NT) {
        u32x4 a[2], b[2], c[2], d[2];
#pragma unroll
        for (int q = 0; q < 2; ++q) { const size_t i = i0 + (size_t)q * NT; a[q] = *(const u32x4*)(MA + i * 8); b[q] = *(const u32x4*)(MB + i * 8); c[q] = *(const u32x4*)(YA + i * 8); d[q] = *(const u32x4*)(YB + i * 8); }
#pragma unroll
        for (int q = 0; q < 2; ++q) { const size_t i = i0 + (size_t)q * NT;
            float ma[8], mb[8], ya[8], yb[8], r[8];
            unpack8(a[q], ma); unpack8(b[q], mb); unpack8(c[q], ya); unpack8(d[q], yb);
#pragma unroll
            for (int e = 0; e < 8; ++e) r[e] = sigm(ma[e] + ba[e]) * ya[e] + sigm(mb[e] + bb[e]) * (yb[e] + bo[e]);
            *(u32x4*)(MG + i * 8) = pack8(r); }
    }
}

__device__ __forceinline__ void p7_phase(float* out, const bf16_t* Y2, const float* x, const float* mod, const float* fgain, int G) {
    const int lane = threadIdx.x & 63, gw = blockIdx.x * 8 + (threadIdx.x >> 6), NGW = G * 8;
    f32x4 g[4];
#pragma unroll
    for (int j = 0; j < 4; ++j) g[j] = *(const f32x4*)(fgain + 4 * lane + 256 * j);
    for (int row0 = gw; row0 < M; row0 += 2 * NGW) {
        f32x4 v[2][4]; u32x2 y[2][4]; float ss[2];
#pragma unroll
        for (int q = 0; q < 2; ++q) { const size_t ro = (size_t)(row0 + q * NGW) * D; const f32x4* xr = (const f32x4*)(x + ro) + lane; const u32x2* yr = (const u32x2*)(Y2 + ro) + lane;
#pragma unroll
            for (int j = 0; j < 4; ++j) { v[q][j] = xr[64 * j]; y[q][j] = yr[64 * j]; } }
#pragma unroll
        for (int q = 0; q < 2; ++q) { const int row = row0 + q * NGW; const f32x4* gt = (const f32x4*)(mod + (size_t)(row >> 12) * 3 * D + 2 * D) + lane; ss[q] = 0.f;
#pragma unroll
            for (int j = 0; j < 4; ++j) { const f32x4 yy = (f32x4){bflo(y[q][j].x), bfhi(y[q][j].x), bflo(y[q][j].y), bfhi(y[q][j].y)};
                v[q][j] = v[q][j] + gt[64 * j] * yy; ss[q] += (v[q][j].x * v[q][j].x + v[q][j].y * v[q][j].y) + (v[q][j].z * v[q][j].z + v[q][j].w * v[q][j].w); } }
#pragma unroll
        for (int q = 0; q < 2; ++q) { f32x4* orow = (f32x4*)(out + (size_t)(row0 + q * NGW) * D) + lane;
            const float r = rsqrtf(wave_sum(ss[q]) * (1.f / D) + EPS);
#pragma unroll
            for (int j = 0; j < 4; ++j) orow[64 * j] = (v[q][j] * r) * g[j]; }
    }
}

#define XB_TMO      128
#define XB_XCNT(j)  (256  + 64 * (j))
#define XB_XSUB(j)  (1280 + 64 * (j))
#define XB_XGEN(j)  (2304 + 64 * (j))
#define XB_TOP      3328
#define XB_TOPGEN   3392
#define XCD_BAR_WORDS 3456
#define XB_SPIN_CAP (1u << 18)
__device__ __forceinline__ unsigned xb_ld(unsigned* p)              { return __hip_atomic_load(p, __ATOMIC_RELAXED, __HIP_MEMORY_SCOPE_AGENT); }
__device__ __forceinline__ unsigned xb_add(unsigned* p, unsigned v) { return __hip_atomic_fetch_add(p, v, __ATOMIC_RELAXED, __HIP_MEMORY_SCOPE_AGENT); }
__device__ __forceinline__ unsigned xb_xcc_id() { return (unsigned)__builtin_amdgcn_s_getreg((3 << 11) | 20) & 0xFu; }
#define XB_SPIN(cond, bar) do { unsigned _sp = 0; while (cond) { __builtin_amdgcn_s_sleep(1); \
    if ((++_sp & 255u) == 0u) { if (xb_ld(&(bar)[XB_TMO])) break; if (_sp > XB_SPIN_CAP) { atomicAdd(&(bar)[XB_TMO], 1u); break; } } } } while (0)
struct XcdBarrier { unsigned* bar; unsigned x; volatile LAS unsigned* st; };
__device__ __forceinline__ XcdBarrier xcd_barrier_post(unsigned* bar, volatile LAS unsigned* st) {
    XcdBarrier b; b.bar = bar; b.x = xb_xcc_id(); b.st = st;
    if (threadIdx.x == 0) (void)xb_add(&bar[XB_XCNT(b.x)], 1u);
    return b;
}
__device__ __forceinline__ void xcd_barrier_complete(unsigned* bar, unsigned x, unsigned& nloc, unsigned& nx) {
    const unsigned G = gridDim.x * gridDim.y * gridDim.z;
    unsigned sum, cnt, mine, sp = 0u;
    for (;;) {
        sum = 0u; cnt = 0u; mine = 0u;
#pragma unroll
        for (unsigned j = 0; j < 16; ++j) { const unsigned c = xb_ld(&bar[XB_XCNT(j)]); sum += c; cnt += (c > 0u) ? 1u : 0u; mine = (j == x) ? c : mine; }
        if (sum == G) break;
        __builtin_amdgcn_s_sleep(1);
        if ((++sp & 255u) == 0u) { if (xb_ld(&bar[XB_TMO])) break; if (sp > XB_SPIN_CAP) { atomicAdd(&bar[XB_TMO], 1u); break; } }
    }
    nloc = mine > 0u ? mine : 1u; nx = cnt > 0u ? cnt : 1u;
}
__device__ __forceinline__ void xcd_barrier(const XcdBarrier& b) {
    asm volatile("s_waitcnt vmcnt(0)" ::: "memory");
    __syncthreads();
    if (threadIdx.x == 0) {
        unsigned* bar = b.bar;
        __builtin_amdgcn_s_waitcnt(0);
        unsigned nloc = b.st[0], nx = b.st[1];
        if (nloc == 0u) { xcd_barrier_complete(bar, b.x, nloc, nx); b.st[0] = nloc; b.st[1] = nx; }
        const unsigned old = xb_add(&bar[XB_XSUB(b.x)], 1u);
        const unsigned gen = old / nloc;
        if (old + 1u == (gen + 1u) * nloc) {
            __builtin_amdgcn_fence(__ATOMIC_RELEASE, "agent");
            asm volatile("s_waitcnt vmcnt(0)" ::: "memory");
            const unsigned og = xb_add(&bar[XB_TOP], 1u);
            const unsigned tg = og / nx;
            if (og + 1u == (tg + 1u) * nx) xb_add(&bar[XB_TOPGEN], 1u);
            else XB_SPIN(xb_ld(&bar[XB_TOPGEN]) == tg, bar);
            __builtin_amdgcn_fence(__ATOMIC_ACQUIRE, "agent");
            xb_add(&bar[XB_XGEN(b.x)], 1u);
            asm volatile("s_waitcnt vmcnt(0)" ::: "memory");
        } else {
            XB_SPIN(xb_ld(&bar[XB_XGEN(b.x)]) == gen, bar);
            __builtin_amdgcn_fence(__ATOMIC_ACQUIRE, "agent");
            asm volatile("s_waitcnt vmcnt(0)" ::: "memory");
        }
    }
    __syncthreads();
}

struct Args { const float* in[17]; float* out; unsigned char* ws; int ph_lo, ph_hi; };

__global__ void __launch_bounds__(512, 2) fwd_kernel(Args a) {
    extern __shared__ __attribute__((aligned(16))) unsigned char shm[];
    LAS unsigned char* lds = (LAS unsigned char*)shm;
    cg::grid_group grid = cg::this_grid();
    const int G = gridDim.x, lo = a.ph_lo, hi = a.ph_hi;
    unsigned char* ws = a.ws;
    bf16_t* act = (bf16_t*)(ws + WS_ACT);
    const float* mod = (const float*)(ws + WS_MOD);
#define IN(k) (lo <= (k) && (k) < hi)
#define SEAM(k) do { if (IN(k) && IN((k) + 1)) { if ((k) == 0) grid.sync(); else xcd_barrier(xbar); } } while (0)
    volatile LAS unsigned* xst = (volatile LAS unsigned*)(lds + 131072);
    if (threadIdx.x < 4) xst[threadIdx.x] = 0u;
    __syncthreads();
    XcdBarrier xbar; xbar.bar = (unsigned*)(ws + WS_BAR); xbar.x = 0; xbar.st = xst;
    if (hi - lo > 1) xbar = xcd_barrier_post((unsigned*)(ws + WS_BAR), xst);
    if (IN(0)) p0_phase(lds, a.in[1], a.in[3], a.in[4], ws, G);
    SEAM(0);
    if (IN(1)) { p0b_phase(lds, a.in[5], a.in[8], a.in[13], a.in[15], ws, G); p1_phase(a.in[0], a.in[2], mod, act, G); }
    SEAM(1);
    if (IN(2)) { pg8::Gemm g{act, (const bf16_t*)(ws + WS_W1T), M, DIN, D}; pg8::StaticOrder S; S.init(M, DIN, G, (int)blockIdx.x);
        Epi1 E{act}; pg8::gemm_phase<Epi1, pg8::StaticOrder, true, true>(lds, g, S, E); }
    SEAM(2);
    if (IN(3)) { p3a_phase(act + 1 * (SLOT / 2), act + 2 * (SLOT / 2), act + 2 * (SLOT / 2), a.in[7], G);
        p3b_phase(lds, act + 3 * (SLOT / 2), act + 3 * (SLOT / 2), act + 4 * (SLOT / 2), a.in[9], a.in[10], a.in[11], a.in[12], G); }
    SEAM(3);
    if (IN(4)) { pg8::Gemm g{act + 2 * (SLOT / 2), (const bf16_t*)(ws + WS_WAB), M, D, D}; pg8::PairOrder S; S.init(M, D, G, (int)blockIdx.x);
        EpiY E{act}; pg8::gemm_phase<EpiY, pg8::PairOrder, true, true>(lds, g, S, E); }
    SEAM(4);
    if (IN(5)) merge_phase(act + 5 * (SLOT / 2), act + 6 * (SLOT / 2), act, act + 1 * (SLOT / 2), act + 4 * (SLOT / 2), a.in[6], a.in[14], G);
    SEAM(5);
    if (IN(6)) { pg8::Gemm g{act + 4 * (SLOT / 2), (const bf16_t*)(ws + WS_WOT), M, D, D}; pg8::StaticOrder S; S.init(M, D, G, (int)blockIdx.x);
        EpiY E{act}; pg8::gemm_phase<EpiY, pg8::StaticOrder, true, true>(lds, g, S, E); }
    SEAM(6);
    if (IN(7)) p7_phase(a.out, act, a.in[0], mod, a.in[16], G);
#undef IN
#undef SEAM
}

extern "C" void kernel_launch(void* const* d_in, const int* in_sizes, int n_in, void* d_out, int out_size, void* d_ws, size_t ws_size, hipStream_t stream) {
    static int grid = 0;
    if (grid == 0) {
        if (n_in != 17 || out_size != M * D || ws_size < WS_END) { fprintf(stderr, "kernel_launch: unexpected shapes (n_in %d out %d ws %zu, need %zu)\n", n_in, out_size, ws_size, (size_t)WS_END); grid = -1; return; }
        int dev = 0, cus = 0, per_cu = 0;
        (void)hipGetDevice(&dev); (void)hipDeviceGetAttribute(&cus, hipDeviceAttributeMultiprocessorCount, dev);
        if (hipFuncSetAttribute((const void*)fwd_kernel, hipFuncAttributeMaxDynamicSharedMemorySize, LDS_BYTES) != hipSuccess) { fprintf(stderr, "kernel_launch: hipFuncSetAttribute failed\n"); grid = -1; return; }
        if (hipOccupancyMaxActiveBlocksPerMultiprocessor(&per_cu, (const void*)fwd_kernel, 512, LDS_BYTES) != hipSuccess || per_cu < 1) { fprintf(stderr, "kernel_launch: occupancy query says %d\n", per_cu); per_cu = 1; }
        (void)hipGetLastError();
        grid = cus;
    }
    if (grid < 0) return;
    Args a{};
    for (int i = 0; i < 17; ++i) a.in[i] = (const float*)d_in[i];
    a.out = (float*)d_out; a.ws = (unsigned char*)d_ws;
#if N_LAUNCHES == 1
    (void)hipMemsetAsync((char*)d_ws + WS_BAR, 0, XCD_BAR_WORDS * 4, stream);
    a.ph_lo = 0; a.ph_hi = 8;
    void* args[] = {&a};
    hipError_t e = hipLaunchCooperativeKernel((const void*)fwd_kernel, dim3(grid), dim3(512), args, LDS_BYTES, stream);
    if (e != hipSuccess) fprintf(stderr, "cooperative launch failed: %s (grid %d)\n", hipGetErrorString(e), grid);
#else
    for (int ph = 0; ph < 8; ++ph) { a.ph_lo = ph; a.ph_hi = ph + 1; hipLaunchKernelGGL(fwd_kernel, dim3(grid), dim3(512), LDS_BYTES, stream, a); }
#endif
}
```

```cpp
#include <hip/hip_runtime.h>
#include <hip/hip_cooperative_groups.h>
#include <cstdio>
namespace cg = cooperative_groups;

#ifndef N_LAUNCHES
#define N_LAUNCHES 1
#endif

#define LAS __attribute__((address_space(3)))
typedef unsigned short bf16_t;
typedef short bf16x8 __attribute__((ext_vector_type(8)));
typedef float f32x4 __attribute__((ext_vector_type(4)));
typedef unsigned u32x4 __attribute__((ext_vector_type(4)));
typedef unsigned u32x2 __attribute__((ext_vector_type(2)));

constexpr int D = 1024, NBATCH = 8, SEQ = 4096, M = NBATCH * SEQ, DIN = 9216;
constexpr float EPS = 1e-6f;
constexpr int LDS_BYTES = 131072 + 16;

constexpr size_t WS_W1T = 0;
constexpr size_t WS_WAB = WS_W1T + (size_t)DIN * D * 2;
constexpr size_t WS_WOT = WS_WAB + (size_t)2 * D * D * 2;
constexpr size_t WS_MOD = WS_WOT + (size_t)D * D * 2;
constexpr size_t WS_BAR = WS_MOD + 98304;
constexpr size_t WS_ACT = WS_MOD + 131072;
constexpr size_t SLOT = (size_t)M * D * 2;
constexpr size_t WS_END = WS_ACT + 7 * SLOT;

__device__ __forceinline__ float bflo(unsigned u) { return __uint_as_float(u << 16); }
__device__ __forceinline__ float bfhi(unsigned u) { return __uint_as_float(u & 0xffff0000u); }
__device__ __forceinline__ unsigned cvt_pk_bf16(float lo, float hi) { unsigned r; asm("v_cvt_pk_bf16_f32 %0, %1, %2" : "=v"(r) : "v"(lo), "v"(hi)); return r; }
__device__ __forceinline__ float sigm(float x) { return __builtin_amdgcn_rcpf(1.0f + __builtin_amdgcn_exp2f(-1.44269504f * x)); }
__device__ __forceinline__ float silu(float x) { return x * sigm(x); }
__device__ __forceinline__ void unpack8(const u32x4 v, float (&f)[8]) {
    f[0] = bflo(v.x); f[1] = bfhi(v.x); f[2] = bflo(v.y); f[3] = bfhi(v.y); f[4] = bflo(v.z); f[5] = bfhi(v.z); f[6] = bflo(v.w); f[7] = bfhi(v.w);
}
__device__ __forceinline__ u32x4 pack8(const float (&f)[8]) {
    u32x4 o; o.x = cvt_pk_bf16(f[0], f[1]); o.y = cvt_pk_bf16(f[2], f[3]); o.z = cvt_pk_bf16(f[4], f[5]); o.w = cvt_pk_bf16(f[6], f[7]); return o;
}
__device__ __forceinline__ float wave_sum(float v) {
#pragma unroll
    for (int o = 1; o < 64; o <<= 1) v += __shfl_xor(v, o);
    return v;
}
__device__ __forceinline__ float half_sum(float v) {
#pragma unroll
    for (int o = 1; o < 32; o <<= 1) v += __shfl_xor(v, o);
    return v;
}

namespace pg8 {
constexpr int BM = 256, BK = 64, HALF = 128, HTB = HALF * BK * 2, STAGE_BYTES = 8 * HTB, NXCD = 8, WGM = 8;
__host__ __device__ __forceinline__ int lds_byte(int r, int c) { const int st = (r >> 4) * 2 + (c >> 5), rr = r & 15, cc = c & 31, ob = rr * 64 + cc * 2; return st * 1024 + (ob ^ (((ob >> 9) & 1) << 5)); }
__host__ __device__ __forceinline__ void stage_rc(int b, int& R, int& C) { const int st = b / 1024, sb = b % 1024, swz = sb ^ (((sb >> 9) & 1) << 5); R = (st >> 1) * 16 + swz / 64; C = (st & 1) * 32 + (swz % 64) / 2; }
__host__ __device__ __forceinline__ int perm32(int rho) { const int n = rho >> 4, i = rho & 15; return 8 * (i >> 2) + 4 * n + (i & 3); }

struct Unit { int pm, pn; };
struct Gemm { const bf16_t* A; const bf16_t* Bt; int M, N, K; };

struct StaticOrder {
    int nM, nN, nwg, G, c;
    __device__ void init(int M_, int N_, int G_, int c_) { nM = M_ / BM; nN = N_ / BM; nwg = nM * nN; G = G_; c = c_; }
    __device__ bool map(long L, Unit& u) const {
        if (L >= nwg) return false;
        int wgid = (int)L; { const int q = nwg / NXCD, r = nwg % NXCD, xcd = wgid % NXCD, off = wgid / NXCD; wgid = (xcd < r ? xcd * (q + 1) : r * (q + 1) + (xcd - r) * q) + off; }
        const int nig = WGM * nN, gid = wgid / nig, fm = gid * WGM, gsz = (nM - fm) < WGM ? (nM - fm) : WGM;
        u.pm = fm + ((wgid % nig) % gsz); u.pn = (wgid % nig) / gsz; return true;
    }
    __device__ bool next(int i, Unit& u) const { return map((long)i * G + c, u); }
    __device__ __forceinline__ void a_ready(const Unit&) const {}
    __device__ __forceinline__ void done(const Unit&) const {}
};
struct PairOrder : StaticOrder {
    __device__ bool next(int i, Unit& u) const {
        const int j = i >> 1, h = i & 1;
        if (!map((long)j * G + c, u)) return false;
        u.pm += h * nM; u.pn += h * nN; return true;
    }
};

struct PairOrder1 : StaticOrder {
    int base;
    __device__ bool next(int i, Unit& u) const {
        if (i >= 2) return false;
        if (!map((long)base * G + c, u)) return false;
        u.pm += i * nM; u.pn += i * nN; return true;
    }
};
template <class Epi, class Sched, bool ALIGN_EPI = false, bool SP2 = false>
__device__ __forceinline__ void gemm_phase(LAS unsigned char* lds, const Gemm g, const Sched& S, const Epi& E) {
    const int tid = threadIdx.x, wid = __builtin_amdgcn_readfirstlane(tid >> 6), lane = tid & 63, wr = wid >> 2, wc = wid & 3, fr = lane & 15, fq = lane >> 4;
    const int K = g.K, nt = K / BK;
    unsigned voffA[2], voffB[2];
#pragma unroll
    for (int i = 0; i < 2; ++i) { int R, C; stage_rc(tid * 16 + i * 8192, R, C); const int Rb = Epi::PERM ? ((R & ~31) + perm32(R & 31)) : R;
        voffA[i] = (unsigned)(R * K + C) * 2u; voffB[i] = (unsigned)(Rb * K + C) * 2u; }
    const size_t kstep = (size_t)(BK * 2);
    const size_t hstep = (size_t)HALF * K * 2;
    const size_t tstep = 2 * hstep;
    const unsigned ldsw = (unsigned)wid * 1024u;
    const int aoff = lds_byte(wr * 64 + fr, fq * 8), boff = lds_byte(wc * 32 + fr, fq * 8);
#define PG8_SA(b, h) (((b) * 2 + (h)) * HTB)
#define PG8_SB(b, h) ((4 + (b) * 2 + (h)) * HTB)
#define PG8_STAGE(bufoff, gbase, voff) do { _Pragma("unroll") for (int _i = 0; _i < 2; ++_i) \
        __builtin_amdgcn_global_load_lds((const unsigned*)((const char*)(gbase) + (voff)[_i]), (LAS unsigned*)(lds + (bufoff) + ldsw + _i * 8192), 16, 0, 0); } while (0)
#define PG8_LDA(dst, b, h) do { _Pragma("unroll") for (int m = 0; m < 4; ++m) _Pragma("unroll") for (int k = 0; k < 2; ++k) dst[m][k] = *(const LAS bf16x8*)(lds + PG8_SA(b, h) + aoff + m * 2048 + k * 1024); } while (0)
#define PG8_LDB(dst, b, h) do { _Pragma("unroll") for (int n = 0; n < 2; ++n) _Pragma("unroll") for (int k = 0; k < 2; ++k) dst[n][k] = *(const LAS bf16x8*)(lds + PG8_SB(b, h) + boff + n * 2048 + k * 1024); } while (0)
#define PG8_MMA(ai, bj, At, Bt) do { __builtin_amdgcn_s_setprio(1); _Pragma("unroll") for (int m = 0; m < 4; ++m) _Pragma("unroll") for (int n = 0; n < 2; ++n) _Pragma("unroll") for (int k = 0; k < 2; ++k) \
        acc[ai][bj][m][n] = __builtin_amdgcn_mfma_f32_16x16x32_bf16(Bt[n][k], At[m][k], acc[ai][bj][m][n], 0, 0, 0); __builtin_amdgcn_s_setprio(0); } while (0)
#define PG8_WAIT_V(n) asm volatile("s_waitcnt vmcnt(" #n ")" ::: "memory")
#define PG8_WAIT_L(n) asm volatile("s_waitcnt lgkmcnt(" #n ")" ::: "memory")
#define PG8_BAR __builtin_amdgcn_s_barrier()
#define PG8_SCHED __builtin_amdgcn_sched_barrier(0)
    Unit cur, nxt; int ui = 0;
    if (!S.next(0, cur)) return;
    f32x4 acc[2][2][4][2];
#pragma unroll
    for (int a = 0; a < 2; ++a)
#pragma unroll
        for (int b = 0; b < 2; ++b)
#pragma unroll
            for (int m = 0; m < 4; ++m)
#pragma unroll
                for (int n = 0; n < 2; ++n) acc[a][b][m][n] = (f32x4){0.f, 0.f, 0.f, 0.f};
    bf16x8 At[4][2], B0[2][2], B1[2][2];
    const char* cA = (const char*)g.A + (size_t)cur.pm * tstep; const char* cB = (const char*)g.Bt + (size_t)cur.pn * tstep;
    S.a_ready(cur);
    if constexpr (SP2) {
        PG8_STAGE(PG8_SB(0, 0), cB, voffB); PG8_STAGE(PG8_SB(0, 1), cB + hstep, voffB); PG8_STAGE(PG8_SA(0, 0), cA, voffA); PG8_STAGE(PG8_SA(0, 1), cA + hstep, voffA);
        if (wr == 1) PG8_BAR;
        PG8_WAIT_V(2); PG8_BAR;
        PG8_STAGE(PG8_SB(1, 0), cB + kstep, voffB); PG8_STAGE(PG8_SA(1, 0), cA + kstep, voffA); PG8_STAGE(PG8_SB(1, 1), cB + hstep + kstep, voffB);
        PG8_WAIT_V(6); PG8_BAR;
    } else {
        PG8_STAGE(PG8_SB(0, 0), cB, voffB); PG8_STAGE(PG8_SA(0, 0), cA, voffA); PG8_STAGE(PG8_SB(0, 1), cB + hstep, voffB); PG8_STAGE(PG8_SA(0, 1), cA + hstep, voffA);
        if (wr == 1) PG8_BAR;
        PG8_WAIT_V(4); PG8_BAR;
        PG8_STAGE(PG8_SB(1, 0), cB + kstep, voffB); PG8_STAGE(PG8_SA(1, 0), cA + kstep, voffA); PG8_STAGE(PG8_SB(1, 1), cB + hstep + kstep, voffB);
        PG8_WAIT_V(6); PG8_BAR;
    }
    for (;;) {
        const bool has_next = S.next(ui + 1, nxt);
        const char* nA = has_next ? (const char*)g.A + (size_t)nxt.pm * tstep : cA; const char* nB = has_next ? (const char*)g.Bt + (size_t)nxt.pn * tstep : cB;
        for (int t = 0; t < nt; t += 2) {
            const bool last = (t == nt - 2);
            const char* a1 = cA + (size_t)(t + 1) * kstep;
            const char* a2 = last ? nA : cA + (size_t)(t + 2) * kstep; const char* b2 = last ? nB : cB + (size_t)(t + 2) * kstep;
            const char* a3 = a2 + kstep; const char* b3 = b2 + kstep;
            if (last && has_next) S.a_ready(nxt);
            if constexpr (SP2) {
            PG8_LDB(B0, 0, 0); PG8_LDB(B1, 0, 1); PG8_SCHED; PG8_LDA(At, 0, 0); PG8_STAGE(PG8_SA(1, 1), a1 + hstep, voffA);
            PG8_WAIT_V(8); PG8_WAIT_L(0); PG8_BAR; PG8_MMA(0, 0, At, B0); PG8_MMA(0, 1, At, B1); PG8_BAR; PG8_SCHED;
            PG8_LDA(At, 0, 1); PG8_STAGE(PG8_SB(0, 0), b2, voffB); PG8_STAGE(PG8_SB(0, 1), b2 + hstep, voffB); PG8_STAGE(PG8_SA(0, 0), a2, voffA);
            PG8_WAIT_V(8); PG8_WAIT_L(0); PG8_BAR; PG8_MMA(1, 0, At, B0); PG8_MMA(1, 1, At, B1); PG8_BAR; PG8_SCHED;
            PG8_LDB(B0, 1, 0); PG8_LDB(B1, 1, 1); PG8_SCHED; PG8_LDA(At, 1, 0); PG8_STAGE(PG8_SA(0, 1), a2 + hstep, voffA);
            PG8_WAIT_V(8); PG8_WAIT_L(0); PG8_BAR; PG8_MMA(0, 0, At, B0); PG8_MMA(0, 1, At, B1); PG8_BAR; PG8_SCHED;
            PG8_LDA(At, 1, 1); PG8_STAGE(PG8_SB(1, 0), b3, voffB); PG8_STAGE(PG8_SB(1, 1), b3 + hstep, voffB); PG8_STAGE(PG8_SA(1, 0), a3, voffA);
            PG8_WAIT_V(8); PG8_WAIT_L(0); PG8_BAR; PG8_MMA(1, 0, At, B0); PG8_MMA(1, 1, At, B1); PG8_BAR; PG8_SCHED;
            } else {
            PG8_LDB(B0, 0, 0); PG8_SCHED; PG8_LDA(At, 0, 0); PG8_STAGE(PG8_SA(1, 1), a1 + hstep, voffA);
            PG8_WAIT_L(8); PG8_BAR; PG8_WAIT_L(0); PG8_MMA(0, 0, At, B0); PG8_BAR; PG8_SCHED;
            PG8_LDB(B1, 0, 1); PG8_STAGE(PG8_SB(0, 0), b2, voffB);
            PG8_BAR; PG8_WAIT_L(0); PG8_MMA(0, 1, At, B1); PG8_BAR;
            PG8_LDA(At, 0, 1); PG8_STAGE(PG8_SA(0, 0), a2, voffA);
            PG8_BAR; PG8_WAIT_L(0); PG8_MMA(1, 0, At, B0); PG8_BAR; PG8_SCHED;
            PG8_STAGE(PG8_SB(0, 1), b2 + hstep, voffB);
            PG8_WAIT_V(6); PG8_BAR; PG8_MMA(1, 1, At, B1); PG8_BAR;
            PG8_LDB(B0, 1, 0); PG8_SCHED; PG8_LDA(At, 1, 0); PG8_STAGE(PG8_SA(0, 1), a2 + hstep, voffA);
            PG8_WAIT_L(8); PG8_BAR; PG8_WAIT_L(0); PG8_MMA(0, 0, At, B0); PG8_BAR; PG8_SCHED;
            PG8_LDB(B1, 1, 1); PG8_STAGE(PG8_SB(1, 0), b3, voffB);
            PG8_BAR; PG8_WAIT_L(0); PG8_MMA(0, 1, At, B1); PG8_BAR;
            PG8_LDA(At, 1, 1); PG8_STAGE(PG8_SA(1, 0), a3, voffA);
            PG8_BAR; PG8_WAIT_L(0); PG8_MMA(1, 0, At, B0); PG8_BAR; PG8_SCHED;
            PG8_STAGE(PG8_SB(1, 1), b3 + hstep, voffB);
            PG8_WAIT_V(6); PG8_BAR; PG8_MMA(1, 1, At, B1); PG8_BAR;
            }
        }
        if constexpr (ALIGN_EPI) { if (wr == 0) PG8_BAR; }
        E(acc, cur, wr, wc, fr, fq); S.done(cur);
        if (!has_next) break;
#pragma unroll
        for (int a = 0; a < 2; ++a)
#pragma unroll
            for (int b = 0; b < 2; ++b)
#pragma unroll
                for (int m = 0; m < 4; ++m)
#pragma unroll
                    for (int n = 0; n < 2; ++n) acc[a][b][m][n] = (f32x4){0.f, 0.f, 0.f, 0.f};
        cur = nxt; cA = nA; cB = nB; ++ui;
        if constexpr (ALIGN_EPI) { if (wr == 1) PG8_BAR; }
    }
    PG8_WAIT_V(0);
    if constexpr (!ALIGN_EPI) { if (wr == 0) PG8_BAR; }
    PG8_BAR;
#undef PG8_SA
#undef PG8_SB
#undef PG8_STAGE
#undef PG8_LDA
#undef PG8_LDB
#undef PG8_MMA
#undef PG8_WAIT_V
#undef PG8_WAIT_L
#undef PG8_BAR
#undef PG8_SCHED
}
}


struct Epi1 {
    static constexpr bool PERM = true;
    bf16_t* act;
    template <int MODE> __device__ __forceinline__ void pair(const f32x4 (&acc)[2][2][4][2], bf16_t* O, int row0, int col0) const {
#pragma unroll
        for (int ai = 0; ai < 2; ++ai)
#pragma unroll
            for (int m = 0; m < 4; ++m) {
                float r[8];
#pragma unroll
                for (int n = 0; n < 2; ++n)
#pragma unroll
                    for (int j = 0; j < 4; ++j) { const float a = acc[ai][0][m][n][j], b = acc[ai][1][m][n][j];
                        r[4 * n + j] = MODE == 0 ? a * b : (MODE == 1 ? a * silu(b) : a * sigm(b)); }
                *(u32x4*)(O + (size_t)(row0 + ai * 128 + m * 16) * D + col0) = pack8(r);
            }
    }
    template <int MODE> __device__ __forceinline__ void single(const f32x4 (&acc)[2][2][4][2], bf16_t* O, int row0, int col0) const {
#pragma unroll
        for (int bj = 0; bj < 2; ++bj)
#pragma unroll
            for (int ai = 0; ai < 2; ++ai)
#pragma unroll
                for (int m = 0; m < 4; ++m) {
                    float r[8];
#pragma unroll
                    for (int j = 0; j < 4; ++j) { const float v0 = acc[ai][bj][m][0][j], v1 = acc[ai][bj][m][1][j];
                        r[j] = MODE == 0 ? silu(v0) : v0; r[4 + j] = MODE == 0 ? silu(v1) : v1; }
                    *(u32x4*)(O + (size_t)(row0 + ai * 128 + m * 16) * D + col0 + bj * 128) = pack8(r);
                }
    }
    __device__ __forceinline__ void operator()(const f32x4 (&acc)[2][2][4][2], const pg8::Unit& u, int wr, int wc, int fr, int fq) const {
        const int row0 = u.pm * 256 + wr * 64 + fr, tile = u.pn;
        if (tile < 24) {
            const int grp = tile >> 3, col0 = 128 * (tile & 7) + wc * 32 + 8 * fq;
            if (grp == 0) pair<0>(acc, act + 1 * (SLOT / 2), row0, col0);
            else if (grp == 1) pair<1>(acc, act + 2 * (SLOT / 2), row0, col0);
            else pair<2>(acc, act + 4 * (SLOT / 2), row0, col0);
        } else {
            const int t2 = tile - 24, g2 = t2 >> 2, col0 = 256 * (t2 & 3) + wc * 32 + 8 * fq;
            if (g2 == 0) single<0>(acc, act + 3 * (SLOT / 2), row0, col0);
            else single<1>(acc, act + (4 + g2) * (SLOT / 2), row0, col0);
        }
    }
};

struct EpiY {
    static constexpr bool PERM = true;
    bf16_t* Y;
    __device__ __forceinline__ void operator()(const f32x4 (&acc)[2][2][4][2], const pg8::Unit& u, int wr, int wc, int fr, int fq) const {
        const int row0 = u.pm * 256 + wr * 64 + fr, col0 = (u.pn & 3) * 256 + wc * 32 + 8 * fq;
#pragma unroll
        for (int bj = 0; bj < 2; ++bj)
#pragma unroll
            for (int ai = 0; ai < 2; ++ai)
#pragma unroll
                for (int m = 0; m < 4; ++m) {
                    float r[8];
#pragma unroll
                    for (int j = 0; j < 4; ++j) { r[j] = acc[ai][bj][m][0][j]; r[4 + j] = acc[ai][bj][m][1][j]; }
                    *(u32x4*)(Y + (size_t)(row0 + ai * 128 + m * 16) * D + col0 + bj * 128) = pack8(r);
                }
    }
};
__device__ __forceinline__ int w1_srccol(int nc) {
    const int tile = nc >> 8, within = nc & 255;
    if (tile < 24) { const int grp = tile >> 3, half = within >> 7, ch = 128 * (tile & 7) + (within & 127);
        const int split = grp == 0 ? (half ? 2 : 1) : (grp == 1 ? (half ? 3 : 0) : (half ? 5 : 4));
        return split * 1024 + ch; }
    const int t2 = tile - 24;
    return (6 + (t2 >> 2)) * 1024 + 256 * (t2 & 3) + within;
}
__device__ __forceinline__ void transpose_item(const float* W, int ldw, int srccol0, bf16_t* WT, int row0, int k0, LAS float* scr, int lane) {
#pragma unroll 8
    for (int i = 0; i < 32; ++i) { const int kk = 2 * i + (lane >> 5); scr[kk * 33 + (lane & 31)] = W[(size_t)(k0 + kk) * ldw + srccol0 + (lane & 31)]; }
    asm volatile("s_waitcnt lgkmcnt(0)" ::: "memory");
    const int c = lane & 7;
#pragma unroll
    for (int j = 0; j < 4; ++j) { const int n = (lane >> 3) + 8 * j; const LAS float* s = scr + (8 * c) * 33 + n;
        u32x4 o; o.x = cvt_pk_bf16(s[0 * 33], s[1 * 33]); o.y = cvt_pk_bf16(s[2 * 33], s[3 * 33]); o.z = cvt_pk_bf16(s[4 * 33], s[5 * 33]); o.w = cvt_pk_bf16(s[6 * 33], s[7 * 33]);
        *(u32x4*)(WT + (size_t)(row0 + n) * D + k0 + 8 * c) = o; }
    asm volatile("s_waitcnt lgkmcnt(0)" ::: "memory");
}
__device__ __forceinline__ void p0_phase(LAS unsigned char* lds, const float* c, const float* w_ada, const float* b_ada, unsigned char* ws, int G) {
    const int tid = threadIdx.x, lane = tid & 63, wave = tid >> 6;
    float* mod = (float*)(ws + WS_MOD);
    for (int item = blockIdx.x; item < 192; item += G) {
        LAS float* cact = (LAS float*)lds;
        LAS float* red = (LAS float*)(lds + 32768);
        for (int i = tid; i < NBATCH * D; i += 512) cact[i] = silu(c[i]);
        __syncthreads();
        const int col = tid & 15, kg = tid >> 4, j = item * 16 + col;
        float a[8];
#pragma unroll
        for (int b = 0; b < 8; ++b) a[b] = 0.f;
#pragma unroll 8
        for (int kk = 0; kk < 32; ++kk) { const int k = kg * 32 + kk; const float w = w_ada[(size_t)k * (3 * D) + j];
#pragma unroll
            for (int b = 0; b < 8; ++b) a[b] = fmaf(cact[b * D + k], w, a[b]); }
#pragma unroll
        for (int b = 0; b < 8; ++b) red[(b * 16 + col) * 33 + kg] = a[b];
        __syncthreads();
        if (tid < 128) { const int b = tid >> 4, cl = tid & 15; float s = 0.f;
            for (int q = 0; q < 32; ++q) s += red[(b * 16 + cl) * 33 + q];
            mod[b * 3 * D + item * 16 + cl] = s + b_ada[item * 16 + cl]; }
        __syncthreads();
    }
}
__device__ __forceinline__ void p0b_phase(LAS unsigned char* lds, const float* w_in, const float* w_out_a, const float* w_out_b, const float* w_o, unsigned char* ws, int G) {
    const int tid = threadIdx.x, lane = tid & 63, wave = tid >> 6;
    LAS float* scr = (LAS float*)(lds + wave * 8448);
    const int gw = blockIdx.x * 8 + wave, NGW = G * 8;
    bf16_t* W1T = (bf16_t*)(ws + WS_W1T); bf16_t* WAB = (bf16_t*)(ws + WS_WAB); bf16_t* WOT = (bf16_t*)(ws + WS_WOT);
    constexpr int I1 = 16 * (DIN / 32), I2 = 16 * (D / 32);
    for (int it = gw; it < I1 + 3 * I2; it += NGW) {
        int r = it;
        if (r < I1) { const int kb = r / (DIN / 32), nb = r % (DIN / 32); transpose_item(w_in, DIN, w1_srccol(nb * 32), W1T, nb * 32, kb * 64, scr, lane); continue; }
        r -= I1;
        const int which = r / I2; r -= which * I2;
        const int kb = r / (D / 32), nb = r % (D / 32);
        if (which == 0) transpose_item(w_out_a, D, nb * 32, WAB, nb * 32, kb * 64, scr, lane);
        else if (which == 1) transpose_item(w_out_b, D, nb * 32, WAB, D + nb * 32, kb * 64, scr, lane);
        else transpose_item(w_o, D, nb * 32, WOT, nb * 32, kb * 64, scr, lane);
    }
}

__device__ __forceinline__ void p1_phase(const float* x, const float* gain, const float* mod, bf16_t* H, int G) {
    const int lane = threadIdx.x & 63, gw = blockIdx.x * 8 + (threadIdx.x >> 6), NGW = G * 8;
    for (int row0 = gw; row0 < M; row0 += 2 * NGW) {
        f32x4 v[2][4]; float ss[2];
#pragma unroll
        for (int q = 0; q < 2; ++q) { const f32x4* xr = (const f32x4*)(x + (size_t)(row0 + q * NGW) * D) + lane; ss[q] = 0.f;
#pragma unroll
            for (int j = 0; j < 4; ++j) v[q][j] = xr[64 * j]; }
#pragma unroll
        for (int q = 0; q < 2; ++q) {
#pragma unroll
            for (int j = 0; j < 4; ++j) ss[q] += (v[q][j].x * v[q][j].x + v[q][j].y * v[q][j].y) + (v[q][j].z * v[q][j].z + v[q][j].w * v[q][j].w); }
#pragma unroll
        for (int q = 0; q < 2; ++q) { const int row = row0 + q * NGW;
            const float r = rsqrtf(wave_sum(ss[q]) * (1.f / D) + EPS);
            const float* shift = mod + (size_t)(row >> 12) * 3 * D; const float* scale = shift + D;
#pragma unroll
            for (int j = 0; j < 4; ++j) { const int cidx = 4 * lane + 256 * j;
                const f32x4 g = *(const f32x4*)(gain + cidx), sc = *(const f32x4*)(scale + cidx), sh = *(const f32x4*)(shift + cidx);
                const f32x4 h = (v[q][j] * r) * g * (1.0f + sc) + sh;
                u32x2 o; o.x = cvt_pk_bf16(h.x, h.y); o.y = cvt_pk_bf16(h.z, h.w);
                *(u32x2*)(H + (size_t)row * D + cidx) = o; } }
    }
}

__device__ __forceinline__ void p3a_phase(const bf16_t* CV, const bf16_t* BZ, bf16_t* AA, const float* wa, int G) {
    const int gt = blockIdx.x * 512 + threadIdx.x, NT = G * 512;
    for (int item = gt; item < (M / 4) * (D / 8); item += NT) {
        const int tq = item >> 7, cb = (item & 127) * 8, t0 = tq * 4, p0 = t0 & (SEQ - 1);
        float w0[8], w1[8], w2[8];
        { const f32x4 a = *(const f32x4*)(wa + cb), b = *(const f32x4*)(wa + cb + 4), c2 = *(const f32x4*)(wa + D + cb), d = *(const f32x4*)(wa + D + cb + 4),
              e2 = *(const f32x4*)(wa + 2 * D + cb), f = *(const f32x4*)(wa + 2 * D + cb + 4);
#pragma unroll
          for (int e = 0; e < 4; ++e) { w0[e] = a[e]; w0[4 + e] = b[e]; w1[e] = c2[e]; w1[4 + e] = d[e]; w2[e] = e2[e]; w2[4 + e] = f[e]; } }
        u32x4 rows[6], bzr[4];
#pragma unroll
        for (int i = 0; i < 6; ++i) { const int pos = p0 - 1 + i; rows[i] = (u32x4){0u, 0u, 0u, 0u};
            if (pos >= 0 && pos < SEQ) rows[i] = *(const u32x4*)(CV + (size_t)(t0 - 1 + i) * D + cb); }
#pragma unroll
        for (int j = 0; j < 4; ++j) bzr[j] = *(const u32x4*)(BZ + (size_t)(t0 + j) * D + cb);
#pragma unroll
        for (int j = 0; j < 4; ++j) { float a[8], b[8], c[8], bz[8], r[8];
            unpack8(rows[j], a); unpack8(rows[j + 1], b); unpack8(rows[j + 2], c); unpack8(bzr[j], bz);
#pragma unroll
            for (int e = 0; e < 8; ++e) r[e] = bz[e] * (w0[e] * a[e] + w1[e] * b[e] + w2[e] * c[e]);
            *(u32x4*)(AA + (size_t)(t0 + j) * D + cb) = pack8(r); }
    }
}
__device__ __forceinline__ void p3b_phase(LAS unsigned char* lds, const bf16_t* SZ, bf16_t* AB, const bf16_t* U, const float* wb, const float* cbias, const float* lng, const float* lnb, int G) {
    const int tid = threadIdx.x, co = tid & 31, tg = tid >> 5;
    LAS unsigned char* ut = lds;
    LAS unsigned char* wt = lds + 49152;
    for (int tile = blockIdx.x; tile < M / 64; tile += G) {
        const int t0 = tile * 64, p0 = t0 & (SEQ - 1);
        u32x4 pk[4][4];
        float s1[4], s2[4];
#pragma unroll
        for (int j = 0; j < 4; ++j) { s1[j] = 0.f; s2[j] = 0.f; }
#pragma unroll
        for (int ch = 0; ch < 4; ++ch) {
            __syncthreads();
            int c0 = ch * 256; asm volatile("" : "+s"(c0) :: "memory");
            const int cb = c0 + co * 8;
            {   const bf16_t* ug = U + (size_t)(t0 - 15 + tg) * D + c0 + co * 8; LAS unsigned char* ul = ut + tg * 512 + co * 16;
#pragma unroll
                for (int it = 0; it < 6; ++it) { const int r = it * 16 + tg, pos = p0 - 15 + r;
                    if (it < 5 || tg < 14) { u32x4 v = (u32x4){0u, 0u, 0u, 0u};
                        if (pos >= 0 && pos < SEQ) v = *(const u32x4*)(ug + (size_t)it * 16 * D);
                        *(LAS u32x4*)(ul + it * 8192) = v; } }
                const int wv = tid >> 6, cc = tid & 63;
                const float* wg = wb + (size_t)wv * D + c0 + cc * 4; LAS unsigned char* wl = wt + ((wv * 2 + (cc & 1)) * 32 + (cc >> 1)) * 16;
#pragma unroll
                for (int it = 0; it < 4; ++it) { if (it < 3 || wv < 7) *(LAS f32x4*)(wl + it * 8192) = *(const f32x4*)(wg + (size_t)it * 8 * D); } }
            __syncthreads();
            float acc[4][8];
            {   const f32x4 b0 = *(const f32x4*)(cbias + cb), b1 = *(const f32x4*)(cbias + cb + 4);
#pragma unroll
                for (int j = 0; j < 4; ++j)
#pragma unroll
                    for (int e = 0; e < 4; ++e) { acc[j][e] = b0[e]; acc[j][4 + e] = b1[e]; } }
            const LAS unsigned char* ub = ut + (tg * 4) * 512 + co * 16;
            const LAS unsigned char* wp = wt + co * 16;
#pragma unroll 1
            for (int k = 0; k < 30; k += 2) {
                float ur[5][8];
#pragma unroll
                for (int i = 0; i < 5; ++i) unpack8(*(const LAS u32x4*)(ub + (k + i) * 512), ur[i]);
                const f32x4 wa0 = *(const LAS f32x4*)(wp + k * 1024), wa1 = *(const LAS f32x4*)(wp + k * 1024 + 512);
                const f32x4 wb0 = *(const LAS f32x4*)(wp + k * 1024 + 1024), wb1 = *(const LAS f32x4*)(wp + k * 1024 + 1536);
#pragma unroll
                for (int j = 0; j < 4; ++j)
#pragma unroll
                    for (int e = 0; e < 4; ++e) {
                        acc[j][e] = fmaf(wb0[e], ur[j + 1][e], fmaf(wa0[e], ur[j][e], acc[j][e]));
                        acc[j][4 + e] = fmaf(wb1[e], ur[j + 1][4 + e], fmaf(wa1[e], ur[j][4 + e], acc[j][4 + e])); }
            }
            {   float ur[4][8];
#pragma unroll
                for (int i = 0; i < 4; ++i) unpack8(*(const LAS u32x4*)(ub + (30 + i) * 512), ur[i]);
                const f32x4 wa0 = *(const LAS f32x4*)(wp + 30 * 1024), wa1 = *(const LAS f32x4*)(wp + 30 * 1024 + 512);
#pragma unroll
                for (int j = 0; j < 4; ++j)
#pragma unroll
                    for (int e = 0; e < 4; ++e) { acc[j][e] = fmaf(wa0[e], ur[j][e], acc[j][e]); acc[j][4 + e] = fmaf(wa1[e], ur[j][4 + e], acc[j][4 + e]); }
            }
#pragma unroll
            for (int j = 0; j < 4; ++j) {
#pragma unroll
                for (int e = 0; e < 8; ++e) { s1[j] += acc[j][e]; s2[j] = fmaf(acc[j][e], acc[j][e], s2[j]); }
                pk[ch][j] = pack8(acc[j]); }
        }
        float mean[4], rstd[4];
#pragma unroll
        for (int j = 0; j < 4; ++j) { mean[j] = half_sum(s1[j]) * (1.f / D); const float ex2 = half_sum(s2[j]) * (1.f / D);
            rstd[j] = rsqrtf(fmaxf(ex2 - mean[j] * mean[j], 0.f) + EPS); }
#pragma unroll
        for (int ch = 0; ch < 4; ++ch) { int c0 = ch * 256; asm volatile("" : "+s"(c0) :: "memory"); const int cb = c0 + co * 8;
            float g[8], b[8];
            { const f32x4 g0 = *(const f32x4*)(lng + cb), g1 = *(const f32x4*)(lng + cb + 4), b0 = *(const f32x4*)(lnb + cb), b1 = *(const f32x4*)(lnb + cb + 4);
#pragma unroll
              for (int e = 0; e < 4; ++e) { g[e] = g0[e]; g[4 + e] = g1[e]; b[e] = b0[e]; b[4 + e] = b1[e]; } }
#pragma unroll
            for (int j = 0; j < 4; ++j) { const size_t off = (size_t)(t0 + tg * 4 + j) * D + cb;
                float sz[8], v[8], r[8]; unpack8(*(const u32x4*)(SZ + off), sz); unpack8(pk[ch][j], v);
#pragma unroll
                for (int e = 0; e < 8; ++e) { const float y = (v[e] - mean[j]) * rstd[j] * g[e] + b[e]; r[e] = silu(y) * sz[e]; }
                *(u32x4*)(AB + off) = pack8(r); } }
    }
}

__device__ __forceinline__ void merge_phase(const bf16_t* MA, const bf16_t* MB, const bf16_t* YA, const bf16_t* YB, bf16_t* MG, const float* bmerge, const float* bob, int G) {
    const int gt = blockIdx.x * 512 + threadIdx.x, NT = G * 512;
    const int cb = (gt & 127) * 8;
    float ba[8], bb[8], bo[8];
    { const f32x4 a0 = *(const f32x4*)(bmerge + cb), a1 = *(const f32x4*)(bmerge + cb + 4), b0 = *(const f32x4*)(bmerge + D + cb), b1 = *(const f32x4*)(bmerge + D + cb + 4),
          c0 = *(const f32x4*)(bob + cb), c1 = *(const f32x4*)(bob + cb + 4);
#pragma unroll
      for (int e = 0; e < 4; ++e) { ba[e] = a0[e]; ba[4 + e] = a1[e]; bb[e] = b0[e]; bb[4 + e] = b1[e]; bo[e] = c0[e]; bo[4 + e] = c1[e]; } }
    for (size_t i0 = gt; i0 < (size_t)M * D / 8; i0 += 2 * (size_t)NT) {
        u32x4 a[2], b[2], c[2], d[2];
#pragma unroll
        for (int q = 0; q < 2; ++q) { const size_t i = i0 + (size_t)q * NT; a[q] = *(const u32x4*)(MA + i * 8); b[q] = *(const u32x4*)(MB + i * 8); c[q] = *(const u32x4*)(YA + i * 8); d[q] = *(const u32x4*)(YB + i * 8); }
#pragma unroll
        for (int q = 0; q < 2; ++q) { const size_t i = i0 + (size_t)q * NT;
            float ma[8], mb[8], ya[8], yb[8], r[8];
            unpack8(a[q], ma); unpack8(b[q], mb); unpack8(c[q], ya); unpack8(d[q], yb);
#pragma unroll
            for (int e = 0; e < 8; ++e) r[e] = sigm(ma[e] + ba[e]) * ya[e] + sigm(mb[e] + bb[e]) * (yb[e] + bo[e]);
            *(u32x4*)(MG + i * 8) = pack8(r); }
    }
}

__device__ __forceinline__ void merge_tile(const bf16_t* MA, const bf16_t* MB, const bf16_t* YA, const bf16_t* YB, bf16_t* MG, const float* bmerge, const float* bob, int pm, int pn) {
    const int tid = threadIdx.x, oc = tid & 31, r0 = tid >> 5, cb = pn * 256 + oc * 8;
    float ba[8], bb[8], bo[8];
    { const f32x4 a0 = *(const f32x4*)(bmerge + cb), a1 = *(const f32x4*)(bmerge + cb + 4), b0 = *(const f32x4*)(bmerge + D + cb), b1 = *(const f32x4*)(bmerge + D + cb + 4),
          c0 = *(const f32x4*)(bob + cb), c1 = *(const f32x4*)(bob + cb + 4);
#pragma unroll
      for (int e = 0; e < 4; ++e) { ba[e] = a0[e]; ba[4 + e] = a1[e]; bb[e] = b0[e]; bb[4 + e] = b1[e]; bo[e] = c0[e]; bo[4 + e] = c1[e]; } }
#pragma unroll 1
    for (int q0 = 0; q0 < 16; q0 += 2) {
        u32x4 a[2], b[2], c[2], d[2];
#pragma unroll
        for (int q = 0; q < 2; ++q) { const size_t i = (size_t)(pm * 256 + r0 + 16 * (q0 + q)) * D + cb; a[q] = *(const u32x4*)(MA + i); b[q] = *(const u32x4*)(MB + i); c[q] = *(const u32x4*)(YA + i); d[q] = *(const u32x4*)(YB + i); }
#pragma unroll
        for (int q = 0; q < 2; ++q) { const size_t i = (size_t)(pm * 256 + r0 + 16 * (q0 + q)) * D + cb;
            float ma[8], mb[8], ya[8], yb[8], r[8];
            unpack8(a[q], ma); unpack8(b[q], mb); unpack8(c[q], ya); unpack8(d[q], yb);
#pragma unroll
            for (int e = 0; e < 8; ++e) r[e] = sigm(ma[e] + ba[e]) * ya[e] + sigm(mb[e] + bb[e]) * (yb[e] + bo[e]);
            *(u32x4*)(MG + i) = pack8(r); }
    }
}

__device__ __forceinline__ void p7_phase(float* out, const bf16_t* Y2, const float* x, const float* mod, const float* fgain, int G) {
    const int lane = threadIdx.x & 63, gw = blockIdx.x * 8 + (threadIdx.x >> 6), NGW = G * 8;
    f32x4 g[4];
#pragma unroll
    for (int j = 0; j < 4; ++j) g[j] = *(const f32x4*)(fgain + 4 * lane + 256 * j);
    for (int row0 = gw; row0 < M; row0 += 2 * NGW) {
        f32x4 v[2][4]; u32x2 y[2][4]; float ss[2];
#pragma unroll
        for (int q = 0; q < 2; ++q) { const size_t ro = (size_t)(row0 + q * NGW) * D; const f32x4* xr = (const f32x4*)(x + ro) + lane; const u32x2* yr = (const u32x2*)(Y2 + ro) + lane;
#pragma unroll
            for (int j = 0; j < 4; ++j) { v[q][j] = xr[64 * j]; y[q][j] = yr[64 * j]; } }
#pragma unroll
        for (int q = 0; q < 2; ++q) { const int row = row0 + q * NGW; const f32x4* gt = (const f32x4*)(mod + (size_t)(row >> 12) * 3 * D + 2 * D) + lane; ss[q] = 0.f;
#pragma unroll
            for (int j = 0; j < 4; ++j) { const f32x4 yy = (f32x4){bflo(y[q][j].x), bfhi(y[q][j].x), bflo(y[q][j].y), bfhi(y[q][j].y)};
                v[q][j] = v[q][j] + gt[64 * j] * yy; ss[q] += (v[q][j].x * v[q][j].x + v[q][j].y * v[q][j].y) + (v[q][j].z * v[q][j].z + v[q][j].w * v[q][j].w); } }
#pragma unroll
        for (int q = 0; q < 2; ++q) { f32x4* orow = (f32x4*)(out + (size_t)(row0 + q * NGW) * D) + lane;
            const float r = rsqrtf(wave_sum(ss[q]) * (1.f / D) + EPS);
#pragma unroll
            for (int j = 0; j < 4; ++j) orow[64 * j] = (v[q][j] * r) * g[j]; }
    }
}

#define XB_TMO      128
#define XB_XCNT(j)  (256  + 64 * (j))
#define XB_XSUB(j)  (1280 + 64 * (j))
#define XB_XGEN(j)  (2304 + 64 * (j))
#define XB_TOP      3328
#define XB_TOPGEN   3392
#define XCD_BAR_WORDS 3456
#define XB_SPIN_CAP (1u << 18)
__device__ __forceinline__ unsigned xb_ld(unsigned* p)              { return __hip_atomic_load(p, __ATOMIC_RELAXED, __HIP_MEMORY_SCOPE_AGENT); }
__device__ __forceinline__ unsigned xb_add(unsigned* p, unsigned v) { return __hip_atomic_fetch_add(p, v, __ATOMIC_RELAXED, __HIP_MEMORY_SCOPE_AGENT); }
__device__ __forceinline__ unsigned xb_xcc_id() { return (unsigned)__builtin_amdgcn_s_getreg((3 << 11) | 20) & 0xFu; }
#define XB_SPIN(cond, bar) do { unsigned _sp = 0; while (cond) { __builtin_amdgcn_s_sleep(1); \
    if ((++_sp & 255u) == 0u) { if (xb_ld(&(bar)[XB_TMO])) break; if (_sp > XB_SPIN_CAP) { atomicAdd(&(bar)[XB_TMO], 1u); break; } } } } while (0)
struct XcdBarrier { unsigned* bar; unsigned x; volatile LAS unsigned* st; };
__device__ __forceinline__ XcdBarrier xcd_barrier_post(unsigned* bar, volatile LAS unsigned* st) {
    XcdBarrier b; b.bar = bar; b.x = xb_xcc_id(); b.st = st;
    if (threadIdx.x == 0) (void)xb_add(&bar[XB_XCNT(b.x)], 1u);
    return b;
}
__device__ __forceinline__ void xcd_barrier_complete(unsigned* bar, unsigned x, unsigned& nloc, unsigned& nx) {
    const unsigned G = gridDim.x * gridDim.y * gridDim.z;
    unsigned sum, cnt, mine, sp = 0u;
    for (;;) {
        sum = 0u; cnt = 0u; mine = 0u;
#pragma unroll
        for (unsigned j = 0; j < 16; ++j) { const unsigned c = xb_ld(&bar[XB_XCNT(j)]); sum += c; cnt += (c > 0u) ? 1u : 0u; mine = (j == x) ? c : mine; }
        if (sum == G) break;
        __builtin_amdgcn_s_sleep(1);
        if ((++sp & 255u) == 0u) { if (xb_ld(&bar[XB_TMO])) break; if (sp > XB_SPIN_CAP) { atomicAdd(&bar[XB_TMO], 1u); break; } }
    }
    nloc = mine > 0u ? mine : 1u; nx = cnt > 0u ? cnt : 1u;
}
__device__ __forceinline__ void xcd_barrier(const XcdBarrier& b) {
    asm volatile("s_waitcnt vmcnt(0)" ::: "memory");
    __syncthreads();
    if (threadIdx.x == 0) {
        unsigned* bar = b.bar;
        __builtin_amdgcn_s_waitcnt(0);
        unsigned nloc = b.st[0], nx = b.st[1];
        if (nloc == 0u) { xcd_barrier_complete(bar, b.x, nloc, nx); b.st[0] = nloc; b.st[1] = nx; }
        const unsigned old = xb_add(&bar[XB_XSUB(b.x)], 1u);
        const unsigned gen = old / nloc;
        if (old + 1u == (gen + 1u) * nloc) {
            __builtin_amdgcn_fence(__ATOMIC_RELEASE, "agent");
            asm volatile("s_waitcnt vmcnt(0)" ::: "memory");
            const unsigned og = xb_add(&bar[XB_TOP], 1u);
            const unsigned tg = og / nx;
            if (og + 1u == (tg + 1u) * nx) xb_add(&bar[XB_TOPGEN], 1u);
            else XB_SPIN(xb_ld(&bar[XB_TOPGEN]) == tg, bar);
            __builtin_amdgcn_fence(__ATOMIC_ACQUIRE, "agent");
            xb_add(&bar[XB_XGEN(b.x)], 1u);
            asm volatile("s_waitcnt vmcnt(0)" ::: "memory");
        } else {
            XB_SPIN(xb_ld(&bar[XB_XGEN(b.x)]) == gen, bar);
            __builtin_amdgcn_fence(__ATOMIC_ACQUIRE, "agent");
            asm volatile("s_waitcnt vmcnt(0)" ::: "memory");
        }
    }
    __syncthreads();
}

struct Args { const float* in[17]; float* out; unsigned char* ws; int ph_lo, ph_hi; };

__global__ void __launch_bounds__(512, 2) fwd_kernel(Args a) {
    extern __shared__ __attribute__((aligned(16))) unsigned char shm[];
    LAS unsigned char* lds = (LAS unsigned char*)shm;
    cg::grid_group grid = cg::this_grid();
    const int G = gridDim.x, lo = a.ph_lo, hi = a.ph_hi;
    unsigned char* ws = a.ws;
    bf16_t* act = (bf16_t*)(ws + WS_ACT);
    const float* mod = (const float*)(ws + WS_MOD);
#define IN(k) (lo <= (k) && (k) < hi)
#define SEAM(k) do { if (IN(k) && IN((k) + 1)) { if ((k) == 0) grid.sync(); else xcd_barrier(xbar); } } while (0)
    volatile LAS unsigned* xst = (volatile LAS unsigned*)(lds + 131072);
    if (threadIdx.x < 4) xst[threadIdx.x] = 0u;
    __syncthreads();
    XcdBarrier xbar; xbar.bar = (unsigned*)(ws + WS_BAR); xbar.x = 0; xbar.st = xst;
    if (hi - lo > 1) xbar = xcd_barrier_post((unsigned*)(ws + WS_BAR), xst);
    if (IN(0)) p0_phase(lds, a.in[1], a.in[3], a.in[4], ws, G);
    SEAM(0);
    if (IN(1)) { p0b_phase(lds, a.in[5], a.in[8], a.in[13], a.in[15], ws, G); p1_phase(a.in[0], a.in[2], mod, act, G); }
    SEAM(1);
    if (IN(2)) { pg8::Gemm g{act, (const bf16_t*)(ws + WS_W1T), M, DIN, D}; pg8::StaticOrder S; S.init(M, DIN, G, (int)blockIdx.x);
        Epi1 E{act}; pg8::gemm_phase<Epi1, pg8::StaticOrder, true, true>(lds, g, S, E); }
    SEAM(2);
    if (IN(3)) { p3a_phase(act + 1 * (SLOT / 2), act + 2 * (SLOT / 2), act + 2 * (SLOT / 2), a.in[7], G);
        p3b_phase(lds, act + 3 * (SLOT / 2), act + 3 * (SLOT / 2), act + 4 * (SLOT / 2), a.in[9], a.in[10], a.in[11], a.in[12], G); }
    SEAM(3);
    if (IN(4)) { pg8::Gemm g{act + 2 * (SLOT / 2), (const bf16_t*)(ws + WS_WAB), M, D, D}; EpiY E{act};
        for (int j = 0; ; ++j) { pg8::PairOrder1 S; S.init(M, D, G, (int)blockIdx.x); S.base = j; pg8::Unit u;
            if (!S.next(0, u)) break;
            pg8::gemm_phase<EpiY, pg8::PairOrder1, true, true>(lds, g, S, E);
            merge_tile(act + 5 * (SLOT / 2), act + 6 * (SLOT / 2), act, act + 1 * (SLOT / 2), act + 4 * (SLOT / 2), a.in[6], a.in[14], u.pm, u.pn);
            __syncthreads(); } }
    SEAM(4);
    if (IN(5)) { pg8::Gemm g{act + 4 * (SLOT / 2), (const bf16_t*)(ws + WS_WOT), M, D, D}; pg8::StaticOrder S; S.init(M, D, G, (int)blockIdx.x);
        EpiY E{act}; pg8::gemm_phase<EpiY, pg8::StaticOrder, true, true>(lds, g, S, E); }
    SEAM(5);
    if (IN(6)) p7_phase(a.out, act, a.in[0], mod, a.in[16], G);
#undef IN
#undef SEAM
}

extern "C" void kernel_launch(void* const* d_in, const int* in_sizes, int n_in, void* d_out, int out_size, void* d_ws, size_t ws_size, hipStream_t stream) {
    static int grid = 0;
    if (grid == 0) {
        if (n_in != 17 || out_size != M * D || ws_size < WS_END) { fprintf(stderr, "kernel_launch: unexpected shapes (n_in %d out %d ws %zu, need %zu)\n", n_in, out_size, ws_size, (size_t)WS_END); grid = -1; return; }
        int dev = 0, cus = 0, per_cu = 0;
        (void)hipGetDevice(&dev); (void)hipDeviceGetAttribute(&cus, hipDeviceAttributeMultiprocessorCount, dev);
        if (hipFuncSetAttribute((const void*)fwd_kernel, hipFuncAttributeMaxDynamicSharedMemorySize, LDS_BYTES) != hipSuccess) { fprintf(stderr, "kernel_launch: hipFuncSetAttribute failed\n"); grid = -1; return; }
        if (hipOccupancyMaxActiveBlocksPerMultiprocessor(&per_cu, (const void*)fwd_kernel, 512, LDS_BYTES) != hipSuccess || per_cu < 1) { fprintf(stderr, "kernel_launch: occupancy query says %d\n", per_cu); per_cu = 1; }
        (void)hipGetLastError();
        grid = cus;
    }
    if (grid < 0) return;
    Args a{};
    for (int i = 0; i < 17; ++i) a.in[i] = (const float*)d_in[i];
    a.out = (float*)d_out; a.ws = (unsigned char*)d_ws;
#if N_LAUNCHES == 1
    (void)hipMemsetAsync((char*)d_ws + WS_BAR, 0, XCD_BAR_WORDS * 4, stream);
    a.ph_lo = 0; a.ph_hi = 7;
    void* args[] = {&a};
    hipError_t e = hipLaunchCooperativeKernel((const void*)fwd_kernel, dim3(grid), dim3(512), args, LDS_BYTES, stream);
    if (e != hipSuccess) fprintf(stderr, "cooperative launch failed: %s (grid %d)\n", hipGetErrorString(e), grid);
#else
    for (int ph = 0; ph < 7; ++ph) { a.ph_lo = ph; a.ph_hi = ph + 1; hipLaunchKernelGGL(fwd_kernel, dim3(grid), dim3(512), LDS_BYTES, stream, a); }
#endif
}
```

```cpp
#include <hip/hip_runtime.h>
#include <hip/hip_cooperative_groups.h>
#include <cstdio>
namespace cg = cooperative_groups;

#ifndef N_LAUNCHES
#define N_LAUNCHES 1
#endif

#define LAS __attribute__((address_space(3)))
typedef unsigned short bf16_t;
typedef short bf16x8 __attribute__((ext_vector_type(8)));
typedef float f32x4 __attribute__((ext_vector_type(4)));
typedef unsigned u32x4 __attribute__((ext_vector_type(4)));
typedef unsigned u32x2 __attribute__((ext_vector_type(2)));

constexpr int D = 1024, NBATCH = 8, SEQ = 4096, M = NBATCH * SEQ, DIN = 9216;
constexpr float EPS = 1e-6f;
constexpr int LDS_BYTES = 131072 + 16;

constexpr size_t WS_W1T = 0;
constexpr size_t WS_WAB = WS_W1T + (size_t)DIN * D * 2;
constexpr size_t WS_WOT = WS_WAB + (size_t)2 * D * D * 2;
constexpr size_t WS_MOD = WS_WOT + (size_t)D * D * 2;
constexpr size_t WS_BAR = WS_MOD + 98304;
constexpr size_t WS_ACT = WS_MOD + 131072;
constexpr size_t SLOT = (size_t)M * D * 2;
constexpr size_t WS_END = WS_ACT + 7 * SLOT;

__device__ __forceinline__ float bflo(unsigned u) { return __uint_as_float(u << 16); }
__device__ __forceinline__ float bfhi(unsigned u) { return __uint_as_float(u & 0xffff0000u); }
__device__ __forceinline__ unsigned cvt_pk_bf16(float lo, float hi) { unsigned r; asm("v_cvt_pk_bf16_f32 %0, %1, %2" : "=v"(r) : "v"(lo), "v"(hi)); return r; }
__device__ __forceinline__ float sigm(float x) { return __builtin_amdgcn_rcpf(1.0f + __builtin_amdgcn_exp2f(-1.44269504f * x)); }
__device__ __forceinline__ float silu(float x) { return x * sigm(x); }
__device__ __forceinline__ void unpack8(const u32x4 v, float (&f)[8]) {
    f[0] = bflo(v.x); f[1] = bfhi(v.x); f[2] = bflo(v.y); f[3] = bfhi(v.y); f[4] = bflo(v.z); f[5] = bfhi(v.z); f[6] = bflo(v.w); f[7] = bfhi(v.w);
}
__device__ __forceinline__ u32x4 pack8(const float (&f)[8]) {
    u32x4 o; o.x = cvt_pk_bf16(f[0], f[1]); o.y = cvt_pk_bf16(f[2], f[3]); o.z = cvt_pk_bf16(f[4], f[5]); o.w = cvt_pk_bf16(f[6], f[7]); return o;
}
__device__ __forceinline__ float wave_sum(float v) {
#pragma unroll
    for (int o = 1; o < 64; o <<= 1) v += __shfl_xor(v, o);
    return v;
}
__device__ __forceinline__ float half_sum(float v) {
#pragma unroll
    for (int o = 1; o < 32; o <<= 1) v += __shfl_xor(v, o);
    return v;
}

namespace pg8 {
constexpr int BM = 256, BK = 64, HALF = 128, HTB = HALF * BK * 2, STAGE_BYTES = 8 * HTB, NXCD = 8, WGM = 8;
__host__ __device__ __forceinline__ int lds_byte(int r, int c) { const int st = (r >> 4) * 2 + (c >> 5), rr = r & 15, cc = c & 31, ob = rr * 64 + cc * 2; return st * 1024 + (ob ^ (((ob >> 9) & 1) << 5)); }
__host__ __device__ __forceinline__ void stage_rc(int b, int& R, int& C) { const int st = b / 1024, sb = b % 1024, swz = sb ^ (((sb >> 9) & 1) << 5); R = (st >> 1) * 16 + swz / 64; C = (st & 1) * 32 + (swz % 64) / 2; }
__host__ __device__ __forceinline__ int perm32(int rho) { const int n = rho >> 4, i = rho & 15; return 8 * (i >> 2) + 4 * n + (i & 3); }

struct Unit { int pm, pn; };
struct Gemm { const bf16_t* A; const bf16_t* Bt; int M, N, K; };

struct StaticOrder {
    int nM, nN, nwg, G, c;
    __device__ void init(int M_, int N_, int G_, int c_) { nM = M_ / BM; nN = N_ / BM; nwg = nM * nN; G = G_; c = c_; }
    __device__ bool map(long L, Unit& u) const {
        if (L >= nwg) return false;
        int wgid = (int)L; { const int q = nwg / NXCD, r = nwg % NXCD, xcd = wgid % NXCD, off = wgid / NXCD; wgid = (xcd < r ? xcd * (q + 1) : r * (q + 1) + (xcd - r) * q) + off; }
        const int nig = WGM * nN, gid = wgid / nig, fm = gid * WGM, gsz = (nM - fm) < WGM ? (nM - fm) : WGM;
        u.pm = fm + ((wgid % nig) % gsz); u.pn = (wgid % nig) / gsz; return true;
    }
    __device__ bool next(int i, Unit& u) const { return map((long)i * G + c, u); }
    __device__ __forceinline__ void a_ready(const Unit&) const {}
    __device__ __forceinline__ void done(const Unit&) const {}
};
struct PairOrder : StaticOrder {
    __device__ bool next(int i, Unit& u) const {
        const int j = i >> 1, h = i & 1;
        if (!map((long)j * G + c, u)) return false;
        u.pm += h * nM; u.pn += h * nN; return true;
    }
};

struct PairOrder1 : StaticOrder {
    int base;
    __device__ bool next(int i, Unit& u) const {
        if (i >= 2) return false;
        if (!map((long)base * G + c, u)) return false;
        u.pm += i * nM; u.pn += i * nN; return true;
    }
};
template <class Epi, class Sched, bool ALIGN_EPI = false, bool SP2 = false>
__device__ __forceinline__ void gemm_phase(LAS unsigned char* lds, const Gemm g, const Sched& S, const Epi& E) {
    const int tid = threadIdx.x, wid = __builtin_amdgcn_readfirstlane(tid >> 6), lane = tid & 63, wr = wid >> 2, wc = wid & 3, fr = lane & 15, fq = lane >> 4;
    const int K = g.K, nt = K / BK;
    unsigned voffA[2], voffB[2];
#pragma unroll
    for (int i = 0; i < 2; ++i) { int R, C; stage_rc(tid * 16 + i * 8192, R, C); const int Rb = Epi::PERM ? ((R & ~31) + perm32(R & 31)) : R;
        voffA[i] = (unsigned)(R * K + C) * 2u; voffB[i] = (unsigned)(Rb * K + C) * 2u; }
    const size_t kstep = (size_t)(BK * 2);
    const size_t hstep = (size_t)HALF * K * 2;
    const size_t tstep = 2 * hstep;
    const unsigned ldsw = (unsigned)wid * 1024u;
    const int aoff = lds_byte(wr * 64 + fr, fq * 8), boff = lds_byte(wc * 32 + fr, fq * 8);
#define PG8_SA(b, h) (((b) * 2 + (h)) * HTB)
#define PG8_SB(b, h) ((4 + (b) * 2 + (h)) * HTB)
#define PG8_STAGE(bufoff, gbase, voff) do { _Pragma("unroll") for (int _i = 0; _i < 2; ++_i) \
        __builtin_amdgcn_global_load_lds((const unsigned*)((const char*)(gbase) + (voff)[_i]), (LAS unsigned*)(lds + (bufoff) + ldsw + _i * 8192), 16, 0, 0); } while (0)
#define PG8_LDA(dst, b, h) do { _Pragma("unroll") for (int m = 0; m < 4; ++m) _Pragma("unroll") for (int k = 0; k < 2; ++k) dst[m][k] = *(const LAS bf16x8*)(lds + PG8_SA(b, h) + aoff + m * 2048 + k * 1024); } while (0)
#define PG8_LDB(dst, b, h) do { _Pragma("unroll") for (int n = 0; n < 2; ++n) _Pragma("unroll") for (int k = 0; k < 2; ++k) dst[n][k] = *(const LAS bf16x8*)(lds + PG8_SB(b, h) + boff + n * 2048 + k * 1024); } while (0)
#define PG8_MMA(ai, bj, At, Bt) do { __builtin_amdgcn_s_setprio(1); _Pragma("unroll") for (int m = 0; m < 4; ++m) _Pragma("unroll") for (int n = 0; n < 2; ++n) _Pragma("unroll") for (int k = 0; k < 2; ++k) \
        acc[ai][bj][m][n] = __builtin_amdgcn_mfma_f32_16x16x32_bf16(Bt[n][k], At[m][k], acc[ai][bj][m][n], 0, 0, 0); __builtin_amdgcn_s_setprio(0); } while (0)
#define PG8_WAIT_V(n) asm volatile("s_waitcnt vmcnt(" #n ")" ::: "memory")
#define PG8_WAIT_L(n) asm volatile("s_waitcnt lgkmcnt(" #n ")" ::: "memory")
#define PG8_BAR __builtin_amdgcn_s_barrier()
#define PG8_SCHED __builtin_amdgcn_sched_barrier(0)
    Unit cur, nxt; int ui = 0;
    if (!S.next(0, cur)) return;
    f32x4 acc[2][2][4][2];
#pragma unroll
    for (int a = 0; a < 2; ++a)
#pragma unroll
        for (int b = 0; b < 2; ++b)
#pragma unroll
            for (int m = 0; m < 4; ++m)
#pragma unroll
                for (int n = 0; n < 2; ++n) acc[a][b][m][n] = (f32x4){0.f, 0.f, 0.f, 0.f};
    bf16x8 At[4][2], B0[2][2], B1[2][2];
    const char* cA = (const char*)g.A + (size_t)cur.pm * tstep; const char* cB = (const char*)g.Bt + (size_t)cur.pn * tstep;
    S.a_ready(cur);
    if constexpr (SP2) {
        PG8_STAGE(PG8_SB(0, 0), cB, voffB); PG8_STAGE(PG8_SB(0, 1), cB + hstep, voffB); PG8_STAGE(PG8_SA(0, 0), cA, voffA); PG8_STAGE(PG8_SA(0, 1), cA + hstep, voffA);
        if (wr == 1) PG8_BAR;
        PG8_WAIT_V(2); PG8_BAR;
        PG8_STAGE(PG8_SB(1, 0), cB + kstep, voffB); PG8_STAGE(PG8_SA(1, 0), cA + kstep, voffA); PG8_STAGE(PG8_SB(1, 1), cB + hstep + kstep, voffB);
        PG8_WAIT_V(6); PG8_BAR;
    } else {
        PG8_STAGE(PG8_SB(0, 0), cB, voffB); PG8_STAGE(PG8_SA(0, 0), cA, voffA); PG8_STAGE(PG8_SB(0, 1), cB + hstep, voffB); PG8_STAGE(PG8_SA(0, 1), cA + hstep, voffA);
        if (wr == 1) PG8_BAR;
        PG8_WAIT_V(4); PG8_BAR;
        PG8_STAGE(PG8_SB(1, 0), cB + kstep, voffB); PG8_STAGE(PG8_SA(1, 0), cA + kstep, voffA); PG8_STAGE(PG8_SB(1, 1), cB + hstep + kstep, voffB);
        PG8_WAIT_V(6); PG8_BAR;
    }
    for (;;) {
        const bool has_next = S.next(ui + 1, nxt);
        const char* nA = has_next ? (const char*)g.A + (size_t)nxt.pm * tstep : cA; const char* nB = has_next ? (const char*)g.Bt + (size_t)nxt.pn * tstep : cB;
        for (int t = 0; t < nt; t += 2) {
            const bool last = (t == nt - 2);
            const char* a1 = cA + (size_t)(t + 1) * kstep;
            const char* a2 = last ? nA : cA + (size_t)(t + 2) * kstep; const char* b2 = last ? nB : cB + (size_t)(t + 2) * kstep;
            const char* a3 = a2 + kstep; const char* b3 = b2 + kstep;
            if (last && has_next) S.a_ready(nxt);
            if constexpr (SP2) {
            PG8_LDB(B0, 0, 0); PG8_LDB(B1, 0, 1); PG8_SCHED; PG8_LDA(At, 0, 0); PG8_STAGE(PG8_SA(1, 1), a1 + hstep, voffA);
            PG8_WAIT_V(8); PG8_WAIT_L(0); PG8_BAR; PG8_MMA(0, 0, At, B0); PG8_MMA(0, 1, At, B1); PG8_BAR; PG8_SCHED;
            PG8_LDA(At, 0, 1); PG8_STAGE(PG8_SB(0, 0), b2, voffB); PG8_STAGE(PG8_SB(0, 1), b2 + hstep, voffB); PG8_STAGE(PG8_SA(0, 0), a2, voffA);
            PG8_WAIT_V(8); PG8_WAIT_L(0); PG8_BAR; PG8_MMA(1, 0, At, B0); PG8_MMA(1, 1, At, B1); PG8_BAR; PG8_SCHED;
            PG8_LDB(B0, 1, 0); PG8_LDB(B1, 1, 1); PG8_SCHED; PG8_LDA(At, 1, 0); PG8_STAGE(PG8_SA(0, 1), a2 + hstep, voffA);
            PG8_WAIT_V(8); PG8_WAIT_L(0); PG8_BAR; PG8_MMA(0, 0, At, B0); PG8_MMA(0, 1, At, B1); PG8_BAR; PG8_SCHED;
            PG8_LDA(At, 1, 1); PG8_STAGE(PG8_SB(1, 0), b3, voffB); PG8_STAGE(PG8_SB(1, 1), b3 + hstep, voffB); PG8_STAGE(PG8_SA(1, 0), a3, voffA);
            PG8_WAIT_V(8); PG8_WAIT_L(0); PG8_BAR; PG8_MMA(1, 0, At, B0); PG8_MMA(1, 1, At, B1); PG8_BAR; PG8_SCHED;
            } else {
            PG8_LDB(B0, 0, 0); PG8_SCHED; PG8_LDA(At, 0, 0); PG8_STAGE(PG8_SA(1, 1), a1 + hstep, voffA);
            PG8_WAIT_L(8); PG8_BAR; PG8_WAIT_L(0); PG8_MMA(0, 0, At, B0); PG8_BAR; PG8_SCHED;
            PG8_LDB(B1, 0, 1); PG8_STAGE(PG8_SB(0, 0), b2, voffB);
            PG8_BAR; PG8_WAIT_L(0); PG8_MMA(0, 1, At, B1); PG8_BAR;
            PG8_LDA(At, 0, 1); PG8_STAGE(PG8_SA(0, 0), a2, voffA);
            PG8_BAR; PG8_WAIT_L(0); PG8_MMA(1, 0, At, B0); PG8_BAR; PG8_SCHED;
            PG8_STAGE(PG8_SB(0, 1), b2 + hstep, voffB);
            PG8_WAIT_V(6); PG8_BAR; PG8_MMA(1, 1, At, B1); PG8_BAR;
            PG8_LDB(B0, 1, 0); PG8_SCHED; PG8_LDA(At, 1, 0); PG8_STAGE(PG8_SA(0, 1), a2 + hstep, voffA);
            PG8_WAIT_L(8); PG8_BAR; PG8_WAIT_L(0); PG8_MMA(0, 0, At, B0); PG8_BAR; PG8_SCHED;
            PG8_LDB(B1, 1, 1); PG8_STAGE(PG8_SB(1, 0), b3, voffB);
            PG8_BAR; PG8_WAIT_L(0); PG8_MMA(0, 1, At, B1); PG8_BAR;
            PG8_LDA(At, 1, 1); PG8_STAGE(PG8_SA(1, 0), a3, voffA);
            PG8_BAR; PG8_WAIT_L(0); PG8_MMA(1, 0, At, B0); PG8_BAR; PG8_SCHED;
            PG8_STAGE(PG8_SB(1, 1), b3 + hstep, voffB);
            PG8_WAIT_V(6); PG8_BAR; PG8_MMA(1, 1, At, B1); PG8_BAR;
            }
        }
        if constexpr (ALIGN_EPI) { if (wr == 0) PG8_BAR; }
        E(acc, cur, wr, wc, fr, fq); S.done(cur);
        if (!has_next) break;
#pragma unroll
        for (int a = 0; a < 2; ++a)
#pragma unroll
            for (int b = 0; b < 2; ++b)
#pragma unroll
                for (int m = 0; m < 4; ++m)
#pragma unroll
                    for (int n = 0; n < 2; ++n) acc[a][b][m][n] = (f32x4){0.f, 0.f, 0.f, 0.f};
        cur = nxt; cA = nA; cB = nB; ++ui;
        if constexpr (ALIGN_EPI) { if (wr == 1) PG8_BAR; }
    }
    PG8_WAIT_V(0);
    if constexpr (!ALIGN_EPI) { if (wr == 0) PG8_BAR; }
    PG8_BAR;
#undef PG8_SA
#undef PG8_SB
#undef PG8_STAGE
#undef PG8_LDA
#undef PG8_LDB
#undef PG8_MMA
#undef PG8_WAIT_V
#undef PG8_WAIT_L
#undef PG8_BAR
#undef PG8_SCHED
}
}


struct Epi1 {
    static constexpr bool PERM = true;
    bf16_t* act;
    template <int MODE> __device__ __forceinline__ void pair(const f32x4 (&acc)[2][2][4][2], bf16_t* O, int row0, int col0) const {
#pragma unroll
        for (int ai = 0; ai < 2; ++ai)
#pragma unroll
            for (int m = 0; m < 4; ++m) {
                float r[8];
#pragma unroll
                for (int n = 0; n < 2; ++n)
#pragma unroll
                    for (int j = 0; j < 4; ++j) { const float a = acc[ai][0][m][n][j], b = acc[ai][1][m][n][j];
                        r[4 * n + j] = MODE == 0 ? a * b : (MODE == 1 ? a * silu(b) : a * sigm(b)); }
                *(u32x4*)(O + (size_t)(row0 + ai * 128 + m * 16) * D + col0) = pack8(r);
            }
    }
    template <int MODE> __device__ __forceinline__ void single(const f32x4 (&acc)[2][2][4][2], bf16_t* O, int row0, int col0) const {
#pragma unroll
        for (int bj = 0; bj < 2; ++bj)
#pragma unroll
            for (int ai = 0; ai < 2; ++ai)
#pragma unroll
                for (int m = 0; m < 4; ++m) {
                    float r[8];
#pragma unroll
                    for (int j = 0; j < 4; ++j) { const float v0 = acc[ai][bj][m][0][j], v1 = acc[ai][bj][m][1][j];
                        r[j] = MODE == 0 ? silu(v0) : v0; r[4 + j] = MODE == 0 ? silu(v1) : v1; }
                    *(u32x4*)(O + (size_t)(row0 + ai * 128 + m * 16) * D + col0 + bj * 128) = pack8(r);
                }
    }
    __device__ __forceinline__ void operator()(const f32x4 (&acc)[2][2][4][2], const pg8::Unit& u, int wr, int wc, int fr, int fq) const {
        const int row0 = u.pm * 256 + wr * 64 + fr, tile = u.pn;
        if (tile < 24) {
            const int grp = tile >> 3, col0 = 128 * (tile & 7) + wc * 32 + 8 * fq;
            if (grp == 0) pair<0>(acc, act + 1 * (SLOT / 2), row0, col0);
            else if (grp == 1) pair<1>(acc, act + 2 * (SLOT / 2), row0, col0);
            else pair<2>(acc, act + 4 * (SLOT / 2), row0, col0);
        } else {
            const int t2 = tile - 24, g2 = t2 >> 2, col0 = 256 * (t2 & 3) + wc * 32 + 8 * fq;
            if (g2 == 0) single<0>(acc, act + 3 * (SLOT / 2), row0, col0);
            else single<1>(acc, act + (4 + g2) * (SLOT / 2), row0, col0);
        }
    }
};

struct EpiY {
    static constexpr bool PERM = true;
    bf16_t* Y;
    __device__ __forceinline__ void operator()(const f32x4 (&acc)[2][2][4][2], const pg8::Unit& u, int wr, int wc, int fr, int fq) const {
        const int row0 = u.pm * 256 + wr * 64 + fr, col0 = (u.pn & 3) * 256 + wc * 32 + 8 * fq;
#pragma unroll
        for (int bj = 0; bj < 2; ++bj)
#pragma unroll
            for (int ai = 0; ai < 2; ++ai)
#pragma unroll
                for (int m = 0; m < 4; ++m) {
                    float r[8];
#pragma unroll
                    for (int j = 0; j < 4; ++j) { r[j] = acc[ai][bj][m][0][j]; r[4 + j] = acc[ai][bj][m][1][j]; }
                    *(u32x4*)(Y + (size_t)(row0 + ai * 128 + m * 16) * D + col0 + bj * 128) = pack8(r);
                }
    }
};
__device__ __forceinline__ int w1_srccol(int nc) {
    const int tile = nc >> 8, within = nc & 255;
    if (tile < 24) { const int grp = tile >> 3, half = within >> 7, ch = 128 * (tile & 7) + (within & 127);
        const int split = grp == 0 ? (half ? 2 : 1) : (grp == 1 ? (half ? 3 : 0) : (half ? 5 : 4));
        return split * 1024 + ch; }
    const int t2 = tile - 24;
    return (6 + (t2 >> 2)) * 1024 + 256 * (t2 & 3) + within;
}
__device__ __forceinline__ void transpose_item(const float* W, int ldw, int srccol0, bf16_t* WT, int row0, int k0, LAS float* scr, int lane) {
#pragma unroll 8
    for (int i = 0; i < 32; ++i) { const int kk = 2 * i + (lane >> 5); scr[kk * 33 + (lane & 31)] = W[(size_t)(k0 + kk) * ldw + srccol0 + (lane & 31)]; }
    asm volatile("s_waitcnt lgkmcnt(0)" ::: "memory");
    const int c = lane & 7;
#pragma unroll
    for (int j = 0; j < 4; ++j) { const int n = (lane >> 3) + 8 * j; const LAS float* s = scr + (8 * c) * 33 + n;
        u32x4 o; o.x = cvt_pk_bf16(s[0 * 33], s[1 * 33]); o.y = cvt_pk_bf16(s[2 * 33], s[3 * 33]); o.z = cvt_pk_bf16(s[4 * 33], s[5 * 33]); o.w = cvt_pk_bf16(s[6 * 33], s[7 * 33]);
        *(u32x4*)(WT + (size_t)(row0 + n) * D + k0 + 8 * c) = o; }
    asm volatile("s_waitcnt lgkmcnt(0)" ::: "memory");
}
__device__ __forceinline__ void p0_phase(LAS unsigned char* lds, const float* c, const float* w_ada, const float* b_ada, unsigned char* ws, int G) {
    const int tid = threadIdx.x, lane = tid & 63, wave = tid >> 6;
    float* mod = (float*)(ws + WS_MOD);
    for (int item = blockIdx.x; item < 192; item += G) {
        LAS float* cact = (LAS float*)lds;
        LAS float* red = (LAS float*)(lds + 32768);
        for (int i = tid; i < NBATCH * D; i += 512) cact[i] = silu(c[i]);
        __syncthreads();
        const int col = tid & 15, kg = tid >> 4, j = item * 16 + col;
        float a[8];
#pragma unroll
        for (int b = 0; b < 8; ++b) a[b] = 0.f;
#pragma unroll 8
        for (int kk = 0; kk < 32; ++kk) { const int k = kg * 32 + kk; const float w = w_ada[(size_t)k * (3 * D) + j];
#pragma unroll
            for (int b = 0; b < 8; ++b) a[b] = fmaf(cact[b * D + k], w, a[b]); }
#pragma unroll
        for (int b = 0; b < 8; ++b) red[(b * 16 + col) * 33 + kg] = a[b];
        __syncthreads();
        if (tid < 128) { const int b = tid >> 4, cl = tid & 15; float s = 0.f;
            for (int q = 0; q < 32; ++q) s += red[(b * 16 + cl) * 33 + q];
            mod[b * 3 * D + item * 16 + cl] = s + b_ada[item * 16 + cl]; }
        __syncthreads();
    }
}
__device__ __forceinline__ void p0b_phase(LAS unsigned char* lds, const float* w_in, const float* w_out_a, const float* w_out_b, const float* w_o, unsigned char* ws, int G) {
    const int tid = threadIdx.x, lane = tid & 63, wave = tid >> 6;
    LAS float* scr = (LAS float*)(lds + wave * 8448);
    const int gw = blockIdx.x * 8 + wave, NGW = G * 8;
    bf16_t* W1T = (bf16_t*)(ws + WS_W1T); bf16_t* WAB = (bf16_t*)(ws + WS_WAB); bf16_t* WOT = (bf16_t*)(ws + WS_WOT);
    constexpr int I1 = 16 * (DIN / 32), I2 = 16 * (D / 32);
    for (int it = gw; it < I1 + 3 * I2; it += NGW) {
        int r = it;
        if (r < I1) { const int kb = r / (DIN / 32), nb = r % (DIN / 32); transpose_item(w_in, DIN, w1_srccol(nb * 32), W1T, nb * 32, kb * 64, scr, lane); continue; }
        r -= I1;
        const int which = r / I2; r -= which * I2;
        const int kb = r / (D / 32), nb = r % (D / 32);
        if (which == 0) transpose_item(w_out_a, D, nb * 32, WAB, nb * 32, kb * 64, scr, lane);
        else if (which == 1) transpose_item(w_out_b, D, nb * 32, WAB, D + nb * 32, kb * 64, scr, lane);
        else transpose_item(w_o, D, nb * 32, WOT, nb * 32, kb * 64, scr, lane);
    }
}

__device__ __forceinline__ void p1_phase(const float* x, const float* gain, const float* mod, bf16_t* H, int G) {
    const int lane = threadIdx.x & 63, gw = blockIdx.x * 8 + (threadIdx.x >> 6), NGW = G * 8;
    for (int row0 = gw; row0 < M; row0 += 2 * NGW) {
        f32x4 v[2][4]; float ss[2];
#pragma unroll
        for (int q = 0; q < 2; ++q) { const f32x4* xr = (const f32x4*)(x + (size_t)(row0 + q * NGW) * D) + lane; ss[q] = 0.f;
#pragma unroll
            for (int j = 0; j < 4; ++j) v[q][j] = xr[64 * j]; }
#pragma unroll
        for (int q = 0; q < 2; ++q) {
#pragma unroll
            for (int j = 0; j < 4; ++j) ss[q] += (v[q][j].x * v[q][j].x + v[q][j].y * v[q][j].y) + (v[q][j].z * v[q][j].z + v[q][j].w * v[q][j].w); }
#pragma unroll
        for (int q = 0; q < 2; ++q) { const int row = row0 + q * NGW;
            const float r = rsqrtf(wave_sum(ss[q]) * (1.f / D) + EPS);
            const float* shift = mod + (size_t)(row >> 12) * 3 * D; const float* scale = shift + D;
#pragma unroll
            for (int j = 0; j < 4; ++j) { const int cidx = 4 * lane + 256 * j;
                const f32x4 g = *(const f32x4*)(gain + cidx), sc = *(const f32x4*)(scale + cidx), sh = *(const f32x4*)(shift + cidx);
                const f32x4 h = (v[q][j] * r) * g * (1.0f + sc) + sh;
                u32x2 o; o.x = cvt_pk_bf16(h.x, h.y); o.y = cvt_pk_bf16(h.z, h.w);
                *(u32x2*)(H + (size_t)row * D + cidx) = o; } }
    }
}

__device__ __forceinline__ void p3a_phase(const bf16_t* CV, const bf16_t* BZ, bf16_t* AA, const float* wa, int G) {
    const int gt = blockIdx.x * 512 + threadIdx.x, NT = G * 512;
    for (int item = gt; item < (M / 4) * (D / 8); item += NT) {
        const int tq = item >> 7, cb = (item & 127) * 8, t0 = tq * 4, p0 = t0 & (SEQ - 1);
        float w0[8], w1[8], w2[8];
        { const f32x4 a = *(const f32x4*)(wa + cb), b = *(const f32x4*)(wa + cb + 4), c2 = *(const f32x4*)(wa + D + cb), d = *(const f32x4*)(wa + D + cb + 4),
              e2 = *(const f32x4*)(wa + 2 * D + cb), f = *(const f32x4*)(wa + 2 * D + cb + 4);
#pragma unroll
          for (int e = 0; e < 4; ++e) { w0[e] = a[e]; w0[4 + e] = b[e]; w1[e] = c2[e]; w1[4 + e] = d[e]; w2[e] = e2[e]; w2[4 + e] = f[e]; } }
        u32x4 rows[6], bzr[4];
#pragma unroll
        for (int i = 0; i < 6; ++i) { const int pos = p0 - 1 + i; rows[i] = (u32x4){0u, 0u, 0u, 0u};
            if (pos >= 0 && pos < SEQ) rows[i] = *(const u32x4*)(CV + (size_t)(t0 - 1 + i) * D + cb); }
#pragma unroll
        for (int j = 0; j < 4; ++j) bzr[j] = *(const u32x4*)(BZ + (size_t)(t0 + j) * D + cb);
#pragma unroll
        for (int j = 0; j < 4; ++j) { float a[8], b[8], c[8], bz[8], r[8];
            unpack8(rows[j], a); unpack8(rows[j + 1], b); unpack8(rows[j + 2], c); unpack8(bzr[j], bz);
#pragma unroll
            for (int e = 0; e < 8; ++e) r[e] = bz[e] * (w0[e] * a[e] + w1[e] * b[e] + w2[e] * c[e]);
            *(u32x4*)(AA + (size_t)(t0 + j) * D + cb) = pack8(r); }
    }
}
__device__ __forceinline__ void p3b_phase(LAS unsigned char* lds, const bf16_t* SZ, bf16_t* AB, const bf16_t* U, const float* wb, const float* cbias, const float* lng, const float* lnb, int G) {
    const int tid = threadIdx.x, co = tid & 31, tg = tid >> 5;
    LAS unsigned char* ut = lds;
    LAS unsigned char* wt = lds + 49152;
    for (int tile = blockIdx.x; tile < M / 64; tile += G) {
        const int t0 = tile * 64, p0 = t0 & (SEQ - 1);
        u32x4 pk[4][4];
        float s1[4], s2[4];
#pragma unroll
        for (int j = 0; j < 4; ++j) { s1[j] = 0.f; s2[j] = 0.f; }
#pragma unroll
        for (int ch = 0; ch < 4; ++ch) {
            __syncthreads();
            int c0 = ch * 256; asm volatile("" : "+s"(c0) :: "memory");
            const int cb = c0 + co * 8;
            {   const bf16_t* ug = U + (size_t)(t0 - 15 + tg) * D + c0 + co * 8; LAS unsigned char* ul = ut + tg * 512 + co * 16;
#pragma unroll
                for (int it = 0; it < 6; ++it) { const int r = it * 16 + tg, pos = p0 - 15 + r;
                    if (it < 5 || tg < 14) { u32x4 v = (u32x4){0u, 0u, 0u, 0u};
                        if (pos >= 0 && pos < SEQ) v = *(const u32x4*)(ug + (size_t)it * 16 * D);
                        *(LAS u32x4*)(ul + it * 8192) = v; } }
                const int wv = tid >> 6, cc = tid & 63;
                const float* wg = wb + (size_t)wv * D + c0 + cc * 4; LAS unsigned char* wl = wt + ((wv * 2 + (cc & 1)) * 32 + (cc >> 1)) * 16;
#pragma unroll
                for (int it = 0; it < 4; ++it) { if (it < 3 || wv < 7) *(LAS f32x4*)(wl + it * 8192) = *(const f32x4*)(wg + (size_t)it * 8 * D); } }
            __syncthreads();
            float acc[4][8];
            {   const f32x4 b0 = *(const f32x4*)(cbias + cb), b1 = *(const f32x4*)(cbias + cb + 4);
#pragma unroll
                for (int j = 0; j < 4; ++j)
#pragma unroll
                    for (int e = 0; e < 4; ++e) { acc[j][e] = b0[e]; acc[j][4 + e] = b1[e]; } }
            const LAS unsigned char* ub = ut + (tg * 4) * 512 + co * 16;
            const LAS unsigned char* wp = wt + co * 16;
#pragma unroll 1
            for (int k = 0; k < 30; k += 2) {
                float ur[5][8];
#pragma unroll
                for (int i = 0; i < 5; ++i) unpack8(*(const LAS u32x4*)(ub + (k + i) * 512), ur[i]);
                const f32x4 wa0 = *(const LAS f32x4*)(wp + k * 1024), wa1 = *(const LAS f32x4*)(wp + k * 1024 + 512);
                const f32x4 wb0 = *(const LAS f32x4*)(wp + k * 1024 + 1024), wb1 = *(const LAS f32x4*)(wp + k * 1024 + 1536);
#pragma unroll
                for (int j = 0; j < 4; ++j)
#pragma unroll
                    for (int e = 0; e < 4; ++e) {
                        acc[j][e] = fmaf(wb0[e], ur[j + 1][e], fmaf(wa0[e], ur[j][e], acc[j][e]));
                        acc[j][4 + e] = fmaf(wb1[e], ur[j + 1][4 + e], fmaf(wa1[e], ur[j][4 + e], acc[j][4 + e])); }
            }
            {   float ur[4][8];
#pragma unroll
                for (int i = 0; i < 4; ++i) unpack8(*(const LAS u32x4*)(ub + (30 + i) * 512), ur[i]);
                const f32x4 wa0 = *(const LAS f32x4*)(wp + 30 * 1024), wa1 = *(const LAS f32x4*)(wp + 30 * 1024 + 512);
#pragma unroll
                for (int j = 0; j < 4; ++j)
#pragma unroll
                    for (int e = 0; e < 4; ++e) { acc[j][e] = fmaf(wa0[e], ur[j][e], acc[j][e]); acc[j][4 + e] = fmaf(wa1[e], ur[j][4 + e], acc[j][4 + e]); }
            }
#pragma unroll
            for (int j = 0; j < 4; ++j) {
#pragma unroll
                for (int e = 0; e < 8; ++e) { s1[j] += acc[j][e]; s2[j] = fmaf(acc[j][e], acc[j][e], s2[j]); }
                pk[ch][j] = pack8(acc[j]); }
        }
        float mean[4], rstd[4];
#pragma unroll
        for (int j = 0; j < 4; ++j) { mean[j] = half_sum(s1[j]) * (1.f / D); const float ex2 = half_sum(s2[j]) * (1.f / D);
            rstd[j] = rsqrtf(fmaxf(ex2 - mean[j] * mean[j], 0.f) + EPS); }
#pragma unroll
        for (int ch = 0; ch < 4; ++ch) { int c0 = ch * 256; asm volatile("" : "+s"(c0) :: "memory"); const int cb = c0 + co * 8;
            float g[8], b[8];
            { const f32x4 g0 = *(const f32x4*)(lng + cb), g1 = *(const f32x4*)(lng + cb + 4), b0 = *(const f32x4*)(lnb + cb), b1 = *(const f32x4*)(lnb + cb + 4);
#pragma unroll
              for (int e = 0; e < 4; ++e) { g[e] = g0[e]; g[4 + e] = g1[e]; b[e] = b0[e]; b[4 + e] = b1[e]; } }
#pragma unroll
            for (int j = 0; j < 4; ++j) { const size_t off = (size_t)(t0 + tg * 4 + j) * D + cb;
                float sz[8], v[8], r[8]; unpack8(*(const u32x4*)(SZ + off), sz); unpack8(pk[ch][j], v);
#pragma unroll
                for (int e = 0; e < 8; ++e) { const float y = (v[e] - mean[j]) * rstd[j] * g[e] + b[e]; r[e] = silu(y) * sz[e]; }
                *(u32x4*)(AB + off) = pack8(r); } }
    }
}

__device__ __forceinline__ void merge_phase(const bf16_t* MA, const bf16_t* MB, const bf16_t* YA, const bf16_t* YB, bf16_t* MG, const float* bmerge, const float* bob, int G) {
    const int gt = blockIdx.x * 512 + threadIdx.x, NT = G * 512;
    const int cb = (gt & 127) * 8;
    float ba[8], bb[8], bo[8];
    { const f32x4 a0 = *(const f32x4*)(bmerge + cb), a1 = *(const f32x4*)(bmerge + cb + 4), b0 = *(const f32x4*)(bmerge + D + cb), b1 = *(const f32x4*)(bmerge + D + cb + 4),
          c0 = *(const f32x4*)(bob + cb), c1 = *(const f32x4*)(bob + cb + 4);
#pragma unroll
      for (int e = 0; e < 4; ++e) { ba[e] = a0[e]; ba[4 + e] = a1[e]; bb[e] = b0[e]; bb[4 + e] = b1[e]; bo[e] = c0[e]; bo[4 + e] = c1[e]; } }
    for (size_t i0 = gt; i0 < (size_t)M * D / 8; i0 += 2 * (size_t)NT) {
        u32x4 a[2], b[2], c[2], d[2];
#pragma unroll
        for (int q = 0; q < 2; ++q) { const size_t i = i0 + (size_t)q * NT; a[q] = *(const u32x4*)(MA + i * 8); b[q] = *(const u32x4*)(MB + i * 8); c[q] = *(const u32x4*)(YA + i * 8); d[q] = *(const u32x4*)(YB + i * 8); }
#pragma unroll
        for (int q = 0; q < 2; ++q) { const size_t i = i0 + (size_t)q * NT;
            float ma[8], mb[8], ya[8], yb[8], r[8];
            unpack8(a[q], ma); unpack8(b[q], mb); unpack8(c[q], ya); unpack8(d[q], yb);
#pragma unroll
            for (int e = 0; e < 8; ++e) r[e] = sigm(ma[e] + ba[e]) * ya[e] + sigm(mb[e] + bb[e]) * (yb[e] + bo[e]);
            *(u32x4*)(MG + i * 8) = pack8(r); }
    }
}

__device__ __forceinline__ void merge_tile(const bf16_t* MA, const bf16_t* MB, const bf16_t* YA, const bf16_t* YB, bf16_t* MG, const float* bmerge, const float* bob, int pm, int pn) {
    const int tid = threadIdx.x, oc = tid & 31, r0 = tid >> 5, cb = pn * 256 + oc * 8;
    float ba[8], bb[8], bo[8];
    { const f32x4 a0 = *(const f32x4*)(bmerge + cb), a1 = *(const f32x4*)(bmerge + cb + 4), b0 = *(const f32x4*)(bmerge + D + cb), b1 = *(const f32x4*)(bmerge + D + cb + 4),
          c0 = *(const f32x4*)(bob + cb), c1 = *(const f32x4*)(bob + cb + 4);
#pragma unroll
      for (int e = 0; e < 4; ++e) { ba[e] = a0[e]; ba[4 + e] = a1[e]; bb[e] = b0[e]; bb[4 + e] = b1[e]; bo[e] = c0[e]; bo[4 + e] = c1[e]; } }
#pragma unroll 1
    for (int q0 = 0; q0 < 16; q0 += 2) {
        u32x4 a[2], b[2], c[2], d[2];
#pragma unroll
        for (int q = 0; q < 2; ++q) { const size_t i = (size_t)(pm * 256 + r0 + 16 * (q0 + q)) * D + cb; a[q] = *(const u32x4*)(MA + i); b[q] = *(const u32x4*)(MB + i); c[q] = *(const u32x4*)(YA + i); d[q] = *(const u32x4*)(YB + i); }
#pragma unroll
        for (int q = 0; q < 2; ++q) { const size_t i = (size_t)(pm * 256 + r0 + 16 * (q0 + q)) * D + cb;
            float ma[8], mb[8], ya[8], yb[8], r[8];
            unpack8(a[q], ma); unpack8(b[q], mb); unpack8(c[q], ya); unpack8(d[q], yb);
#pragma unroll
            for (int e = 0; e < 8; ++e) r[e] = sigm(ma[e] + ba[e]) * ya[e] + sigm(mb[e] + bb[e]) * (yb[e] + bo[e]);
            *(u32x4*)(MG + i) = pack8(r); }
    }
}

__device__ __forceinline__ void p7_phase(float* out, const bf16_t* Y2, const float* x, const float* mod, const float* fgain, int G) {
    const int lane = threadIdx.x & 63, gw = blockIdx.x * 8 + (threadIdx.x >> 6), NGW = G * 8;
    f32x4 g[4];
#pragma unroll
    for (int j = 0; j < 4; ++j) g[j] = *(const f32x4*)(fgain + 4 * lane + 256 * j);
    for (int row0 = gw; row0 < M; row0 += 2 * NGW) {
        f32x4 v[2][4]; u32x2 y[2][4]; float ss[2];
#pragma unroll
        for (int q = 0; q < 2; ++q) { const size_t ro = (size_t)(row0 + q * NGW) * D; const f32x4* xr = (const f32x4*)(x + ro) + lane; const u32x2* yr = (const u32x2*)(Y2 + ro) + lane;
#pragma unroll
            for (int j = 0; j < 4; ++j) { v[q][j] = xr[64 * j]; y[q][j] = yr[64 * j]; } }
#pragma unroll
        for (int q = 0; q < 2; ++q) { const int row = row0 + q * NGW; const f32x4* gt = (const f32x4*)(mod + (size_t)(row >> 12) * 3 * D + 2 * D) + lane; ss[q] = 0.f;
#pragma unroll
            for (int j = 0; j < 4; ++j) { const f32x4 yy = (f32x4){bflo(y[q][j].x), bfhi(y[q][j].x), bflo(y[q][j].y), bfhi(y[q][j].y)};
                v[q][j] = v[q][j] + gt[64 * j] * yy; ss[q] += (v[q][j].x * v[q][j].x + v[q][j].y * v[q][j].y) + (v[q][j].z * v[q][j].z + v[q][j].w * v[q][j].w); } }
#pragma unroll
        for (int q = 0; q < 2; ++q) { f32x4* orow = (f32x4*)(out + (size_t)(row0 + q * NGW) * D) + lane;
            const float r = rsqrtf(wave_sum(ss[q]) * (1.f / D) + EPS);
#pragma unroll
            for (int j = 0; j < 4; ++j) orow[64 * j] = (v[q][j] * r) * g[j]; }
    }
}

#define XB_TMO      128
#define XB_XCNT(j)  (256  + 64 * (j))
#define XB_XSUB(j)  (1280 + 64 * (j))
#define XB_XGEN(j)  (2304 + 64 * (j))
#define XB_TOP      3328
#define XB_TOPGEN   3392
#define XCD_BAR_WORDS 3456
#define XB_SPIN_CAP (1u << 18)
__device__ __forceinline__ unsigned xb_ld(unsigned* p)              { return __hip_atomic_load(p, __ATOMIC_RELAXED, __HIP_MEMORY_SCOPE_AGENT); }
__device__ __forceinline__ unsigned xb_add(unsigned* p, unsigned v) { return __hip_atomic_fetch_add(p, v, __ATOMIC_RELAXED, __HIP_MEMORY_SCOPE_AGENT); }
__device__ __forceinline__ unsigned xb_xcc_id() { return (unsigned)__builtin_amdgcn_s_getreg((3 << 11) | 20) & 0xFu; }
#define XB_SPIN(cond, bar) do { unsigned _sp = 0; while (cond) { __builtin_amdgcn_s_sleep(1); \
    if ((++_sp & 255u) == 0u) { if (xb_ld(&(bar)[XB_TMO])) break; if (_sp > XB_SPIN_CAP) { atomicAdd(&(bar)[XB_TMO], 1u); break; } } } } while (0)
struct XcdBarrier { unsigned* bar; unsigned x; volatile LAS unsigned* st; };
__device__ __forceinline__ XcdBarrier xcd_barrier_post(unsigned* bar, volatile LAS unsigned* st) {
    XcdBarrier b; b.bar = bar; b.x = xb_xcc_id(); b.st = st;
    if (threadIdx.x == 0) (void)xb_add(&bar[XB_XCNT(b.x)], 1u);
    return b;
}
__device__ __forceinline__ void xcd_barrier_complete(unsigned* bar, unsigned x, unsigned& nloc, unsigned& nx) {
    const unsigned G = gridDim.x * gridDim.y * gridDim.z;
    unsigned sum, cnt, mine, sp = 0u;
    for (;;) {
        sum = 0u; cnt = 0u; mine = 0u;
#pragma unroll
        for (unsigned j = 0; j < 16; ++j) { const unsigned c = xb_ld(&bar[XB_XCNT(j)]); sum += c; cnt += (c > 0u) ? 1u : 0u; mine = (j == x) ? c : mine; }
        if (sum == G) break;
        __builtin_amdgcn_s_sleep(1);
        if ((++sp & 255u) == 0u) { if (xb_ld(&bar[XB_TMO])) break; if (sp > XB_SPIN_CAP) { atomicAdd(&bar[XB_TMO], 1u); break; } }
    }
    nloc = mine > 0u ? mine : 1u; nx = cnt > 0u ? cnt : 1u;
}
__device__ __forceinline__ void xcd_barrier(const XcdBarrier& b) {
    asm volatile("s_waitcnt vmcnt(0)" ::: "memory");
    __syncthreads();
    if (threadIdx.x == 0) {
        unsigned* bar = b.bar;
        __builtin_amdgcn_s_waitcnt(0);
        unsigned nloc = b.st[0], nx = b.st[1];
        if (nloc == 0u) { xcd_barrier_complete(bar, b.x, nloc, nx); b.st[0] = nloc; b.st[1] = nx; }
        const unsigned old = xb_add(&bar[XB_XSUB(b.x)], 1u);
        const unsigned gen = old / nloc;
        if (old + 1u == (gen + 1u) * nloc) {
            __builtin_amdgcn_fence(__ATOMIC_RELEASE, "agent");
            asm volatile("s_waitcnt vmcnt(0)" ::: "memory");
            const unsigned og = xb_add(&bar[XB_TOP], 1u);
            const unsigned tg = og / nx;
            if (og + 1u == (tg + 1u) * nx) xb_add(&bar[XB_TOPGEN], 1u);
            else XB_SPIN(xb_ld(&bar[XB_TOPGEN]) == tg, bar);
            __builtin_amdgcn_fence(__ATOMIC_ACQUIRE, "agent");
            xb_add(&bar[XB_XGEN(b.x)], 1u);
            asm volatile("s_waitcnt vmcnt(0)" ::: "memory");
        } else {
            XB_SPIN(xb_ld(&bar[XB_XGEN(b.x)]) == gen, bar);
            __builtin_amdgcn_fence(__ATOMIC_ACQUIRE, "agent");
            asm volatile("s_waitcnt vmcnt(0)" ::: "memory");
        }
    }
    __syncthreads();
}

struct Args { const float* in[17]; float* out; unsigned char* ws; int ph_lo, ph_hi; };

__global__ void __launch_bounds__(512, 2) fwd_kernel(Args a) {
    extern __shared__ __attribute__((aligned(16))) unsigned char shm[];
    LAS unsigned char* lds = (LAS unsigned char*)shm;
    cg::grid_group grid = cg::this_grid();
    const int G = gridDim.x, lo = a.ph_lo, hi = a.ph_hi;
    unsigned char* ws = a.ws;
    bf16_t* act = (bf16_t*)(ws + WS_ACT);
    const float* mod = (const float*)(ws + WS_MOD);
#define IN(k) (lo <= (k) && (k) < hi)
#define SEAM(k) do { if (IN(k) && IN((k) + 1)) { if ((k) == 0) grid.sync(); else xcd_barrier(xbar); } } while (0)
    volatile LAS unsigned* xst = (volatile LAS unsigned*)(lds + 131072);
    if (threadIdx.x < 4) xst[threadIdx.x] = 0u;
    __syncthreads();
    XcdBarrier xbar; xbar.bar = (unsigned*)(ws + WS_BAR); xbar.x = 0; xbar.st = xst;
    if (hi - lo > 1 && blockIdx.x == 0) {
        for (int i = threadIdx.x; i < XCD_BAR_WORDS; i += 512) __hip_atomic_store((unsigned*)(ws + WS_BAR) + i, 0u, __ATOMIC_RELAXED, __HIP_MEMORY_SCOPE_AGENT);
        __threadfence(); }
    if (IN(0)) p0_phase(lds, a.in[1], a.in[3], a.in[4], ws, G);
    SEAM(0);
    if (hi - lo > 1) xbar = xcd_barrier_post((unsigned*)(ws + WS_BAR), xst);
    if (IN(1)) { p0b_phase(lds, a.in[5], a.in[8], a.in[13], a.in[15], ws, G); p1_phase(a.in[0], a.in[2], mod, act, G); }
    SEAM(1);
    if (IN(2)) { pg8::Gemm g{act, (const bf16_t*)(ws + WS_W1T), M, DIN, D}; pg8::StaticOrder S; S.init(M, DIN, G, (int)blockIdx.x);
        Epi1 E{act}; pg8::gemm_phase<Epi1, pg8::StaticOrder, true, true>(lds, g, S, E); }
    SEAM(2);
    if (IN(3)) { p3a_phase(act + 1 * (SLOT / 2), act + 2 * (SLOT / 2), act + 2 * (SLOT / 2), a.in[7], G);
        p3b_phase(lds, act + 3 * (SLOT / 2), act + 3 * (SLOT / 2), act + 4 * (SLOT / 2), a.in[9], a.in[10], a.in[11], a.in[12], G); }
    SEAM(3);
    if (IN(4)) { pg8::Gemm g{act + 2 * (SLOT / 2), (const bf16_t*)(ws + WS_WAB), M, D, D}; EpiY E{act};
        for (int j = 0; ; ++j) { pg8::PairOrder1 S; S.init(M, D, G, (int)blockIdx.x); S.base = j; pg8::Unit u;
            if (!S.next(0, u)) break;
            pg8::gemm_phase<EpiY, pg8::PairOrder1, true, true>(lds, g, S, E);
            merge_tile(act + 5 * (SLOT / 2), act + 6 * (SLOT / 2), act, act + 1 * (SLOT / 2), act + 4 * (SLOT / 2), a.in[6], a.in[14], u.pm, u.pn);
            __syncthreads(); } }
    SEAM(4);
    if (IN(5)) { pg8::Gemm g{act + 4 * (SLOT / 2), (const bf16_t*)(ws + WS_WOT), M, D, D}; pg8::StaticOrder S; S.init(M, D, G, (int)blockIdx.x);
        EpiY E{act}; pg8::gemm_phase<EpiY, pg8::StaticOrder, true, true>(lds, g, S, E); }
    SEAM(5);
    if (IN(6)) p7_phase(a.out, act, a.in[0], mod, a.in[16], G);
#undef IN
#undef SEAM
}

extern "C" void kernel_launch(void* const* d_in, const int* in_sizes, int n_in, void* d_out, int out_size, void* d_ws, size_t ws_size, hipStream_t stream) {
    static int grid = 0;
    if (grid == 0) {
        if (n_in != 17 || out_size != M * D || ws_size < WS_END) { fprintf(stderr, "kernel_launch: unexpected shapes (n_in %d out %d ws %zu, need %zu)\n", n_in, out_size, ws_size, (size_t)WS_END); grid = -1; return; }
        int dev = 0, cus = 0, per_cu = 0;
        (void)hipGetDevice(&dev); (void)hipDeviceGetAttribute(&cus, hipDeviceAttributeMultiprocessorCount, dev);
        if (hipFuncSetAttribute((const void*)fwd_kernel, hipFuncAttributeMaxDynamicSharedMemorySize, LDS_BYTES) != hipSuccess) { fprintf(stderr, "kernel_launch: hipFuncSetAttribute failed\n"); grid = -1; return; }
        if (hipOccupancyMaxActiveBlocksPerMultiprocessor(&per_cu, (const void*)fwd_kernel, 512, LDS_BYTES) != hipSuccess || per_cu < 1) { fprintf(stderr, "kernel_launch: occupancy query says %d\n", per_cu); per_cu = 1; }
        (void)hipGetLastError();
        grid = cus;
    }
    if (grid < 0) return;
    Args a{};
    for (int i = 0; i < 17; ++i) a.in[i] = (const float*)d_in[i];
    a.out = (float*)d_out; a.ws = (unsigned char*)d_ws;
#if N_LAUNCHES == 1
    a.ph_lo = 0; a.ph_hi = 7;
    void* args[] = {&a};
    hipError_t e = hipLaunchCooperativeKernel((const void*)fwd_kernel, dim3(grid), dim3(512), args, LDS_BYTES, stream);
    if (e != hipSuccess) fprintf(stderr, "cooperative launch failed: %s (grid %d)\n", hipGetErrorString(e), grid);
#else
    for (int ph = 0; ph < 7; ++ph) { a.ph_lo = ph; a.ph_hi = ph + 1; hipLaunchKernelGGL(fwd_kernel, dim3(grid), dim3(512), LDS_BYTES, stream, a); }
#endif
}
```
